# Optimizing an MI355X kernel written in HIP

```python
import jax
import jax.numpy as jnp
from jax import lax
import numpy as np

D_MODEL = 1024
BATCH = 4
SEQ = 8192
DEPTH = 2

GRID_W = 64
CTX_LEN = 256
N_MIXERS = 2
N_ATT = (DEPTH + 1) // 2
N_RWKV = DEPTH // 2
HEAD_DIM = 64
ATT_Q_HEADS = D_MODEL // HEAD_DIM
ATT_KV_HEADS = ATT_Q_HEADS // 4
ATT_GROUP = ATT_Q_HEADS // ATT_KV_HEADS
WINDOW = 128
BLOCK = 128
ROPE_BASE = 10000.0
RWKV_HEADS = D_MODEL // HEAD_DIM
DECAY_LORA = 64
ICLR_LORA = 64
GATE_LORA = 128
D_FF = 4 * D_MODEL
NORM_EPS = 1e-6
GN_EPS = 64e-5
NEG_INF = -1e30
F32 = jnp.float32

kernel_name = 'hybrid_swa_rwkv7_dit_layers'


def rmsnorm(x, g):
    x32 = x.astype(F32)
    y = x32 * lax.rsqrt(jnp.mean(x32 * x32, axis=-1, keepdims=True) + NORM_EPS)
    return (y * g.astype(F32)).astype(x.dtype)


def rope_1d(t, pos):
    half = t.shape[-1] // 2
    freqs = ROPE_BASE ** (-jnp.arange(half, dtype=F32) / half)
    ang = pos.astype(F32)[:, None, None] * freqs
    cos, sin = jnp.cos(ang), jnp.sin(ang)
    t1, t2 = t[..., :half].astype(F32), t[..., half:].astype(F32)
    return jnp.concatenate([t1 * cos - t2 * sin, t1 * sin + t2 * cos], axis=-1).astype(t.dtype)


def rope_2d(t, rows, cols):
    r = HEAD_DIM // 2
    return jnp.concatenate([rope_1d(t[..., :r], rows), rope_1d(t[..., r:], cols)], axis=-1)


def sq_relu_mlp(h, w1, w2):
    return jnp.square(jax.nn.relu(h @ w1)) @ w2


def attention_mixer(h, hc, w_qkv, q_gain, k_gain, sink, w_o, rows, cols, ctx_out):
    B, S, _ = h.shape
    L = hc.shape[1]
    nq, nk = ATT_Q_HEADS * HEAD_DIM, ATT_KV_HEADS * HEAD_DIM

    def project(t):
        T = t.shape[1]
        qkv = t @ w_qkv
        q = rmsnorm(qkv[..., :nq].reshape(B, T, ATT_Q_HEADS, HEAD_DIM), q_gain)
        k = rmsnorm(qkv[..., nq:nq + nk].reshape(B, T, ATT_KV_HEADS, HEAD_DIM), k_gain)
        v = qkv[..., nq + nk:].reshape(B, T, ATT_KV_HEADS, HEAD_DIM)
        return q, k, v

    q, k, v = project(h)
    q, k = rope_2d(q, rows, cols), rope_2d(k, rows, cols)
    qc, kc, vc = project(hc)
    scale = HEAD_DIM ** -0.5
    sink_logit = sink.astype(F32).reshape(ATT_KV_HEADS, ATT_GROUP, 1, 1)

    nb = S // BLOCK
    qb = q.reshape(B, nb, BLOCK, ATT_KV_HEADS, ATT_GROUP, HEAD_DIM)

    def band(t):
        tp = jnp.pad(t, ((0, 0), (BLOCK, BLOCK), (0, 0), (0, 0))).reshape(B, nb + 2, BLOCK, ATT_KV_HEADS, HEAD_DIM)
        return jnp.concatenate([tp[:, :-2], tp[:, 1:-1], tp[:, 2:]], axis=2)

    kw, vw = band(k), band(v)
    s_win = jnp.einsum('bnqhgd,bnkhd->bnhgqk', qb, kw).astype(F32) * scale
    s_ctx = jnp.einsum('bnqhgd,blhd->bnhgql', qb, kc).astype(F32) * scale
    blk = jnp.arange(nb)[:, None, None] * BLOCK
    qpos = blk + jnp.arange(BLOCK)[None, :, None]
    kpos = blk - BLOCK + jnp.arange(3 * BLOCK)[None, None, :]
    mask = (jnp.abs(kpos - qpos) <= WINDOW) & (kpos >= 0) & (kpos < S)
    s_win = jnp.where(mask[None, :, None, None], s_win, NEG_INF)
    sinks = jnp.broadcast_to(sink_logit, s_win.shape[:-1] + (1,))
    p = jax.nn.softmax(jnp.concatenate([s_win, s_ctx, sinks], axis=-1), axis=-1)
    p_win = p[..., :3 * BLOCK].astype(v.dtype)
    p_ctx = p[..., 3 * BLOCK:3 * BLOCK + L].astype(v.dtype)
    o = jnp.einsum('bnhgqk,bnkhd->bnqhgd', p_win, vw) + jnp.einsum('bnhgql,blhd->bnqhgd', p_ctx, vc)
    y = o.reshape(B, S, D_MODEL) @ w_o
    if not ctx_out:
        return y, None

    qcg = qc.reshape(B, L, ATT_KV_HEADS, ATT_GROUP, HEAD_DIM)
    s_cc = jnp.einsum('blhgd,bmhd->bhglm', qcg, kc).astype(F32) * scale
    sinks_c = jnp.broadcast_to(sink_logit, s_cc.shape[:-1] + (1,))
    pc = jax.nn.softmax(jnp.concatenate([s_cc, sinks_c], axis=-1), axis=-1)[..., :L].astype(vc.dtype)
    yc = jnp.einsum('bhglm,bmhd->blhgd', pc, vc).reshape(B, L, D_MODEL) @ w_o
    return y, yc


def wkv_scan(r, w, k, v, a, b, s0, reverse):
    def step(s, inp):
        r_t, w_t, k_t, v_t, a_t, b_t = inp
        sa = jnp.einsum('bhvk,bhk->bhv', s, a_t)
        s = s * w_t[:, :, None, :] + sa[..., None] * b_t[:, :, None, :] + v_t[..., None] * k_t[:, :, None, :]
        return s, jnp.einsum('bhvk,bhk->bhv', s, r_t)

    xs = tuple(jnp.moveaxis(t, 1, 0) for t in (r, w, k, v, a, b))
    s_final, ys = lax.scan(step, s0, xs, reverse=reverse)
    return s_final, jnp.moveaxis(ys, 0, 1)


def rwkv_features(h, mu, w_rkv, w0, w1, w2, a0, a1, a2, k_k, k_a):
    B, T, _ = h.shape
    hn = (RWKV_HEADS, HEAD_DIM)
    hp = jnp.pad(h, ((0, 0), (1, 1), (0, 0)))
    xx = 0.5 * (hp[:, :-2] + hp[:, 2:]) - h
    xr, xw, xk, xv, xa, xg = [h + xx * mu[m] for m in range(6)]

    def heads(t):
        return t.astype(F32).reshape(B, T, *hn)

    r = heads(xr @ w_rkv[0])
    k = heads(xk @ w_rkv[1])
    v = heads(xv @ w_rkv[2])
    decay = tuple(
        heads(jnp.exp(-jnp.exp(-jax.nn.softplus(-(w0[d] + jnp.tanh(xw @ w1[d]) @ w2[d]).astype(F32)) - 0.5)))
        for d in range(2))
    a = heads(jax.nn.sigmoid((a0 + (xa @ a1) @ a2).astype(F32)))
    kk = k * k_k.astype(F32).reshape(hn)
    kk = kk / jnp.maximum(jnp.sqrt(jnp.sum(kk * kk, axis=-1, keepdims=True)), 1e-12)
    k = k * (1.0 + (a - 1.0) * k_a.astype(F32).reshape(hn))
    return r, k, v, -kk, kk * a, decay, xg


def group_norm(y, g, b):
    hn = (RWKV_HEADS, HEAD_DIM)
    mean = jnp.mean(y, axis=-1, keepdims=True)
    var = jnp.mean(jnp.square(y - mean), axis=-1, keepdims=True)
    return (y - mean) * lax.rsqrt(var + GN_EPS) * g.astype(F32).reshape(hn) + b.astype(F32).reshape(hn)


def rwkv_readout(y_fwd, y_bwd, r, k, v, xg, g1, g2, r_k, gn_g, gn_b, w_o):
    B, T = xg.shape[:2]
    bonus = jnp.sum(r * k * r_k.astype(F32), axis=-1, keepdims=True) * v

    def gate(d):
        return (jax.nn.sigmoid(xg @ g1[d]) @ g2[d]).astype(F32).reshape(B, T, RWKV_HEADS, HEAD_DIM)

    o = (group_norm(y_fwd, gn_g, gn_b) + bonus) * gate(0) + (group_norm(y_bwd, gn_g, gn_b) + bonus) * gate(1)
    return o.reshape(B, T, D_MODEL).astype(xg.dtype) @ w_o


def rwkv_mixer(h, hc, mu, w_rkv, w0, w1, w2, a0, a1, a2, g1, g2, k_k, k_a, r_k, gn_g, gn_b, w_o, ctx_out):
    feat = (mu, w_rkv, w0, w1, w2, a0, a1, a2, k_k, k_a)
    rc, kc, vc, nac, bc, decc, xgc = rwkv_features(hc, *feat)
    r, k, v, na, b, dec, xg = rwkv_features(h, *feat)
    zero = jnp.zeros((h.shape[0], RWKV_HEADS, HEAD_DIM, HEAD_DIM), F32)
    s_fwd, yc_fwd = wkv_scan(rc, decc[0], kc, vc, nac, bc, zero, False)
    s_bwd, yc_bwd = wkv_scan(rc, decc[1], kc, vc, nac, bc, zero, True)
    _, y_fwd = wkv_scan(r, dec[0], k, v, na, b, s_fwd, False)
    _, y_bwd = wkv_scan(r, dec[1], k, v, na, b, s_bwd, True)
    ro = (g1, g2, r_k, gn_g, gn_b, w_o)
    y = rwkv_readout(y_fwd, y_bwd, r, k, v, xg, *ro)
    if not ctx_out:
        return y, None
    return y, rwkv_readout(yc_fwd, yc_bwd, rc, kc, vc, xgc, *ro)


def setup_inputs(seed: int = 0) -> dict:
    key = jax.random.key(seed)
    ks = iter(jax.random.split(key, 40))
    D = D_MODEL

    def nrm(shape, s):
        return jax.random.normal(next(ks), shape, F32) * s

    def unif(shape, lo, hi):
        return jax.random.uniform(next(ks), shape, F32, lo, hi)

    qkv_cols = (ATT_Q_HEADS + 2 * ATT_KV_HEADS) * HEAD_DIM
    return {
        'x': nrm((BATCH, SEQ, D), 1.0),
        'c': nrm((BATCH, D), 1.0),
        'ctx': nrm((BATCH, CTX_LEN, D), 1.0),
        'c_ctx': nrm((D,), 1.0),
        'ada_w': nrm((DEPTH, D, 6 * D), 0.5 * D ** -0.5),
        'ada_b': nrm((DEPTH, 6 * D), 0.01),
        'norm1_g': 1.0 + nrm((DEPTH, D), 0.1),
        'norm2_g': 1.0 + nrm((DEPTH, D), 0.1),
        'mlp_w1': nrm((DEPTH, D, D_FF), D ** -0.5),
        'mlp_w2': nrm((DEPTH, D_FF, D), D_FF ** -0.5),
        'att_w_qkv': nrm((N_ATT, D, qkv_cols), D ** -0.5),
        'att_q_gain': 1.0 + nrm((N_ATT, HEAD_DIM), 0.1),
        'att_k_gain': 1.0 + nrm((N_ATT, HEAD_DIM), 0.1),
        'att_sink': nrm((N_ATT, ATT_Q_HEADS), 1.0),
        'att_w_o': nrm((N_ATT, D, D), D ** -0.5),
        'rwkv_mu': unif((N_RWKV, 6, D), 0.0, 1.0),
        'rwkv_w_rkv': nrm((N_RWKV, 3, D, D), D ** -0.5),
        'rwkv_w0': unif((N_RWKV, 2, D), -6.0, 1.0),
        'rwkv_w1': nrm((N_RWKV, 2, D, DECAY_LORA), D ** -0.5),
        'rwkv_w2': nrm((N_RWKV, 2, DECAY_LORA, D), 0.5 * DECAY_LORA ** -0.5),
        'rwkv_a0': nrm((N_RWKV, D), 0.5),
        'rwkv_a1': nrm((N_RWKV, D, ICLR_LORA), D ** -0.5),
        'rwkv_a2': nrm((N_RWKV, ICLR_LORA, D), ICLR_LORA ** -0.5),
        'rwkv_g1': nrm((N_RWKV, 2, D, GATE_LORA), D ** -0.5),
        'rwkv_g2': nrm((N_RWKV, 2, GATE_LORA, D), GATE_LORA ** -0.5),
        'rwkv_k_k': 0.85 + nrm((N_RWKV, D), 0.05),
        'rwkv_k_a': 1.0 + nrm((N_RWKV, D), 0.05),
        'rwkv_r_k': nrm((N_RWKV, RWKV_HEADS, HEAD_DIM), 0.1),
        'rwkv_gn_g': 1.0 + nrm((N_RWKV, D), 0.1),
        'rwkv_gn_b': nrm((N_RWKV, D), 0.01),
        'rwkv_w_o': nrm((N_RWKV, D, D), D ** -0.5),
    }


def reference(x, c, ctx, c_ctx, ada_w, ada_b, norm1_g, norm2_g, mlp_w1, mlp_w2,
              att_w_qkv, att_q_gain, att_k_gain, att_sink, att_w_o,
              rwkv_mu, rwkv_w_rkv, rwkv_w0, rwkv_w1, rwkv_w2, rwkv_a0, rwkv_a1, rwkv_a2,
              rwkv_g1, rwkv_g2, rwkv_k_k, rwkv_k_a, rwkv_r_k, rwkv_gn_g, rwkv_gn_b, rwkv_w_o):
    S = x.shape[1]
    n_rows = S // GRID_W
    rows = jnp.repeat(jnp.arange(n_rows), GRID_W)
    cols = jnp.tile(jnp.arange(GRID_W), n_rows)
    silu_c = jax.nn.silu(c)[:, None, :]
    silu_cc = jax.nn.silu(c_ctx)[None, None, :]
    xc = ctx
    for i in range(DEPTH):
        ctx_out = i < DEPTH - 1
        j = i // N_MIXERS
        sh1, sc1, gt1, sh2, sc2, gt2 = jnp.split(silu_c @ ada_w[i] + ada_b[i], 6, axis=-1)
        csh1, csc1, cgt1, csh2, csc2, cgt2 = jnp.split(silu_cc @ ada_w[i] + ada_b[i], 6, axis=-1)
        h = rmsnorm(x, norm1_g[i]) * (1.0 + sc1) + sh1
        hc = rmsnorm(xc, norm1_g[i]) * (1.0 + csc1) + csh1
        if i % N_MIXERS == 0:
            y, yc = attention_mixer(h, hc, att_w_qkv[j], att_q_gain[j], att_k_gain[j], att_sink[j],
                                    att_w_o[j], rows, cols, ctx_out)
        else:
            y, yc = rwkv_mixer(h, hc, rwkv_mu[j], rwkv_w_rkv[j], rwkv_w0[j], rwkv_w1[j], rwkv_w2[j],
                               rwkv_a0[j], rwkv_a1[j], rwkv_a2[j], rwkv_g1[j], rwkv_g2[j],
                               rwkv_k_k[j], rwkv_k_a[j], rwkv_r_k[j], rwkv_gn_g[j], rwkv_gn_b[j],
                               rwkv_w_o[j], ctx_out)
        x = x + gt1 * y
        x = x + gt2 * sq_relu_mlp(rmsnorm(x, norm2_g[i]) * (1.0 + sc2) + sh2, mlp_w1[i], mlp_w2[i])
        if ctx_out:
            xc = xc + cgt1 * yc
            xc = xc + cgt2 * sq_relu_mlp(rmsnorm(xc, norm2_g[i]) * (1.0 + csc2) + csh2, mlp_w1[i], mlp_w2[i])
    return x
```

```cpp
#include <hip/hip_runtime.h>
#include <hip/hip_cooperative_groups.h>
#include <cstdio>
namespace cg = cooperative_groups;

#define DI __device__ __forceinline__
typedef _Float16 f16;
typedef _Float16 f16x8 __attribute__((ext_vector_type(8)));
typedef _Float16 f16x4 __attribute__((ext_vector_type(4)));
typedef _Float16 f16x2 __attribute__((ext_vector_type(2)));
typedef short bf16x8 __attribute__((ext_vector_type(8)));
typedef short s16x4 __attribute__((ext_vector_type(4)));
typedef float f32x4 __attribute__((ext_vector_type(4)));
typedef float f32x2 __attribute__((ext_vector_type(2)));
typedef unsigned short u16;

constexpr int T_ALL = 33792, T_LAT = 32768;
constexpr unsigned MiB = 1048576;
constexpr int LDS_HALF = 73728;
constexpr int LDS_BYTES = 2 * LDS_HALF + 64;
constexpr int NPHASE = 17;
#ifndef REPEAT_MASK
#define REPEAT_MASK 0u
#endif

#define XB_TMO      128
#define XB_XCNT(j)  (256  + 64 * (j))
#define XB_XSUB(j)  (1280 + 64 * (j))
#define XB_XGEN(j)  (2304 + 64 * (j))
#define XB_TOP      3328
#define XB_TOPGEN   3392
#define XCD_BAR_WORDS 3456
#define XB_SPIN_CAP (1u << 18)
#define LAS __attribute__((address_space(3)))

__device__ __forceinline__ unsigned xb_ld(unsigned* p)              { return __hip_atomic_load(p, __ATOMIC_RELAXED, __HIP_MEMORY_SCOPE_AGENT); }
__device__ __forceinline__ unsigned xb_add(unsigned* p, unsigned v) { return __hip_atomic_fetch_add(p, v, __ATOMIC_RELAXED, __HIP_MEMORY_SCOPE_AGENT); }
__device__ __forceinline__ unsigned xb_xcc_id() { return (unsigned)__builtin_amdgcn_s_getreg((3 << 11) | 20) & 0xFu; }
#define XB_SPIN(cond, bar) do { unsigned _sp = 0; while (cond) { __builtin_amdgcn_s_sleep(1); \
    if ((++_sp & 255u) == 0u) { if (xb_ld(&(bar)[XB_TMO])) break; if (_sp > XB_SPIN_CAP) { atomicAdd(&(bar)[XB_TMO], 1u); break; } } } } while (0)

struct XcdBarrier {
    unsigned* bar; unsigned x;
    volatile LAS unsigned* st;
};

__device__ __forceinline__ XcdBarrier xcd_barrier_post(unsigned* bar, volatile LAS unsigned* st) {
    XcdBarrier b; b.bar = bar; b.x = xb_xcc_id(); b.st = st;
    if (threadIdx.x == 0) st[2] = xb_add(&bar[XB_XCNT(b.x)], 1u);
    return b;
}
__device__ __forceinline__ void xcd_barrier_complete(unsigned* bar, unsigned x, unsigned& nloc, unsigned& nx) {
    const unsigned G = gridDim.x * gridDim.y * gridDim.z;
    unsigned sum, cnt, mine, sp = 0u;
    for (;;) {
        sum = 0u; cnt = 0u; mine = 0u;
#pragma unroll 1
        for (unsigned j = 0; j < 16; ++j) { const unsigned c = xb_ld(&bar[XB_XCNT(j)]); sum += c; cnt += (c > 0u) ? 1u : 0u; mine = (j == x) ? c : mine; }
        if (sum == G) break;
        __builtin_amdgcn_s_sleep(1);
        if ((++sp & 255u) == 0u) { if (xb_ld(&bar[XB_TMO])) break; if (sp > XB_SPIN_CAP) { atomicAdd(&bar[XB_TMO], 1u); break; } }
    }
    nloc = mine > 0u ? mine : 1u; nx = cnt > 0u ? cnt : 1u;
}

__device__ __forceinline__ void xcd_barrier(const XcdBarrier& b) {
    asm volatile("s_waitcnt vmcnt(0)" ::: "memory");
    __syncthreads();
    if (threadIdx.x == 0) {
        unsigned* bar = b.bar;
        asm volatile("" : "+s"(bar));
        __builtin_amdgcn_s_waitcnt(0);
        unsigned nloc = b.st[0], nx = b.st[1];
        if (nloc == 0u) { xcd_barrier_complete(bar, b.x, nloc, nx); b.st[0] = nloc; b.st[1] = nx; }
        const unsigned old = xb_add(&bar[XB_XSUB(b.x)], 1u);
        const unsigned gen = old / nloc;
        if (old + 1u == (gen + 1u) * nloc) {
            __builtin_amdgcn_fence(__ATOMIC_RELEASE, "agent");
            asm volatile("s_waitcnt vmcnt(0)" ::: "memory");
            const unsigned og = xb_add(&bar[XB_TOP], 1u);
            const unsigned tg = og / nx;
            if (og + 1u == (tg + 1u) * nx) xb_add(&bar[XB_TOPGEN], 1u);
            else XB_SPIN(xb_ld(&bar[XB_TOPGEN]) == tg, bar);
            __builtin_amdgcn_fence(__ATOMIC_ACQUIRE, "agent");
            xb_add(&bar[XB_XGEN(b.x)], 1u);
            asm volatile("s_waitcnt vmcnt(0)" ::: "memory");
        } else {
            XB_SPIN(xb_ld(&bar[XB_XGEN(b.x)]) == gen, bar);
            __builtin_amdgcn_fence(__ATOMIC_ACQUIRE, "agent");
            asm volatile("s_waitcnt vmcnt(0)" ::: "memory");
        }
    }
    __syncthreads();
}


constexpr unsigned OFF_MOD = 0;
constexpr unsigned OFF_ROPE = 256 * 1024;
constexpr unsigned OFF_MU16 = 288 * 1024;
constexpr unsigned OFF_BAR = 512 * 1024;
constexpr unsigned OFF_RK = 1 * MiB;
constexpr unsigned OFF_XC = 4 * MiB;
constexpr unsigned OFF_W2DEC = 8 * MiB;
constexpr unsigned OFF_A2 = 8 * MiB + 256 * 1024;
constexpr unsigned OFF_G2 = 8 * MiB + 384 * 1024;
constexpr unsigned OFF_WO1 = 9 * MiB;
constexpr unsigned ARENA = 12 * MiB;
constexpr unsigned A_H = ARENA, A_Q = ARENA + 66 * MiB, A_K = ARENA + 132 * MiB, A_VT = ARENA + 149 * MiB, A_O = ARENA + 166 * MiB,
                 A_U = ARENA + 66 * MiB;
constexpr unsigned A_WQKV = ARENA + 400 * MiB, A_WO0 = ARENA + 403 * MiB, A_W1_0 = ARENA + 405 * MiB, A_W2_0 = ARENA + 413 * MiB;
constexpr unsigned A_XX = ARENA + 66 * MiB, A_R = ARENA + 132 * MiB, A_KP = ARENA + 198 * MiB, A_V = ARENA + 264 * MiB,
                 A_TW = ARENA + 330 * MiB, A_G = ARENA + 339 * MiB, A_AI = ARENA + 356 * MiB, A_WFEAT = ARENA + 400 * MiB;
constexpr unsigned A_KKN = ARENA, A_BV = ARENA + 66 * MiB, A_YF = ARENA + 361 * MiB, A_YB = ARENA + 425 * MiB;
constexpr unsigned A_W1_1 = ARENA, A_W2_1 = ARENA + 8 * MiB, A_O1 = ARENA + 66 * MiB, A_H2 = ARENA + 132 * MiB, A_U1 = ARENA + 198 * MiB;
constexpr unsigned WS_NEED = ARENA + 489 * MiB;

struct Params {
  const float* in[31];
  float* out;
  unsigned char* ws;
  int ph_lo, ph_hi;
};
typedef const Params __attribute__((address_space(4)))* KParams;
struct PA {
  KParams k;
  float* out;
  unsigned char* ws;
  __device__ __forceinline__ const float* in(int i) const { return k->in[i]; }
};

enum { EPI_QKV = 0, EPI_RES = 1, EPI_MLP1 = 2, EPI_B2 = 3, EPI_FEAT = 4 };
struct GemmArgs {
  const f16* A; const f16* Bt; int lda, ldb, K, MT, NT, epi;
  const float* srcLat; const float* srcCtx; float* dstLat; float* dstCtx; const float* gt;
  f16* dstH;
};

DI int opaque_tid() { int t = threadIdx.x; asm volatile("" : "+v"(t)); return t; }
DI int vtid() { return opaque_tid() & 255; }
DI int vhalf() { return __builtin_amdgcn_readfirstlane((int)(threadIdx.x >> 8)); }
DI int vbid() { return (int)blockIdx.x * 2 + vhalf(); }
DI int vgrid() { return (int)gridDim.x * 2; }
template <class T> DI T* opaque_ptr(T* q) { asm volatile("" : "+s"(q)); return q; }
#define DPP_ADD(v, CTRL) (v) += __builtin_bit_cast(float, __builtin_amdgcn_update_dpp(0, __builtin_bit_cast(int, (v)), (CTRL), 0xf, 0xf, true))
DI float allred16(float x) { DPP_ADD(x, 0xB1); DPP_ADD(x, 0x4E); DPP_ADD(x, 0x141); DPP_ADD(x, 0x128); return x; }
DI float bperm_xor(float v, int lane, int o) { return __builtin_bit_cast(float, __builtin_amdgcn_ds_bpermute((lane ^ o) << 2, __builtin_bit_cast(int, v))); }
DI float wave_sum(float x, int lane) {
  x = allred16(x);
  x += bperm_xor(x, lane, 16);
  x += bperm_xor(x, lane, 32);
  return x;
}
DI unsigned pack_h2(float a, float b) { f16x2 v = {(f16)a, (f16)b}; return __builtin_bit_cast(unsigned, v); }
DI unsigned short bf16_rne(float x) { unsigned u = __float_as_uint(x); u += 0x7fffu + ((u >> 16) & 1u); return (unsigned short)(u >> 16); }
DI unsigned pack_bf2(float a, float b) { return (unsigned)bf16_rne(a) | ((unsigned)bf16_rne(b) << 16); }
DI float sigmoidf_(float x) { return __builtin_amdgcn_rcpf(1.f + __expf(-x)); }
DI float tanhf_(float x) { return 1.f - 2.f * __builtin_amdgcn_rcpf(__expf(2.f * x) + 1.f); }

DI void conv_tile(const float* __restrict__ src, int N, f16* __restrict__ dst, int ldd, int tile, unsigned char* smem, const float* __restrict__ scale = nullptr) {
  float* t = (float*)smem;
  const int tid = vtid();
  const int ntn = N >> 6;
  const int kt = tile / ntn, nt = tile - kt * ntn;
#pragma unroll
  for (int p = 0; p < 4; ++p) {
    int r = (tid >> 4) + 16 * p, c4 = (tid & 15) * 4;
    float4 v = *(const float4*)(src + (size_t)(kt * 64 + r) * N + nt * 64 + c4);
    if (scale) { const float sv = scale[kt * 64 + r]; v.x *= sv; v.y *= sv; v.z *= sv; v.w *= sv; }
    t[r * 65 + c4] = v.x; t[r * 65 + c4 + 1] = v.y; t[r * 65 + c4 + 2] = v.z; t[r * 65 + c4 + 3] = v.w;
  }
  __syncthreads();
  const int n = tid >> 2, ks = (tid & 3) * 16;
  unsigned w[8];
#pragma unroll
  for (int q = 0; q < 8; ++q) w[q] = pack_h2(t[(ks + 2 * q) * 65 + n], t[(ks + 2 * q + 1) * 65 + n]);
  f16* d = dst + (size_t)(nt * 64 + n) * ldd + kt * 64 + ks;
  *(uint4*)d = make_uint4(w[0], w[1], w[2], w[3]);
  *(uint4*)(d + 8) = make_uint4(w[4], w[5], w[6], w[7]);
  __syncthreads();
}
DI void conv_job(const float* src, int K, int N, f16* dst, int ldd, int& base, unsigned char* smem, const float* scale = nullptr) {
  const int ntile = (K >> 6) * (N >> 6);
  const int G = vgrid(), bid = vbid();
  int first = base + ((bid - (base % G) + G) % G);
  for (int gi = first; gi < base + ntile; gi += G) conv_tile(src, N, dst, ldd, gi - base, smem, scale);
  base += ntile;
}

DI void mod_item(const PA& p, int it, unsigned char* smem) {
  const int tid = vtid();
  const int layer = it / 96, n0 = (it % 96) * 64;
  float* sc = (float*)smem;
  float* red = sc + 5120;
  for (int e = tid; e < 5120; e += 256) {
    int r = e >> 10, k = e & 1023;
    float v = (r < 4) ? p.in(1)[r * 1024 + k] : p.in(3)[k];
    sc[e] = v / (1.f + expf(-v));
  }
  __syncthreads();
  const int col = tid & 63, kg = tid >> 6;
  const float* w = p.in(4) + (size_t)layer * 1024 * 6144 + n0 + col;
  float a0 = 0, a1 = 0, a2 = 0, a3 = 0, a4 = 0;
#pragma unroll 8
  for (int k = kg * 256; k < kg * 256 + 256; ++k) {
    float wv = w[(size_t)k * 6144];
    a0 += sc[k] * wv; a1 += sc[1024 + k] * wv; a2 += sc[2048 + k] * wv; a3 += sc[3072 + k] * wv; a4 += sc[4096 + k] * wv;
  }
  red[(kg * 5 + 0) * 64 + col] = a0; red[(kg * 5 + 1) * 64 + col] = a1; red[(kg * 5 + 2) * 64 + col] = a2;
  red[(kg * 5 + 3) * 64 + col] = a3; red[(kg * 5 + 4) * 64 + col] = a4;
  __syncthreads();
  float* mod = (float*)(p.ws + OFF_MOD);
  for (int e = tid; e < 320; e += 256) {
    int r = e >> 6, c = e & 63;
    float s = red[(0 * 5 + r) * 64 + c] + red[(1 * 5 + r) * 64 + c] + red[(2 * 5 + r) * 64 + c] + red[(3 * 5 + r) * 64 + c];
    mod[(layer * 5 + r) * 6144 + n0 + c] = s + p.in(5)[layer * 6144 + n0 + c];
  }
  __syncthreads();
}

DI void phase0(const PA& p, unsigned char* smem) {
  const int bid = vbid(), G = vgrid(), tid = vtid();
  const int gt = bid * 256 + tid;
  float* ropec = (float*)(p.ws + OFF_ROPE);
  float* ropes = ropec + 2048;
  if (gt < 2048) {
    const int e = gt;
    int pos = e >> 4, j = e & 15;
    float f = powf(10000.f, -(float)j / 16.f);
    float ang = (float)pos * f;
    float s, c;
    sincosf(ang, &s, &c);
    ropec[e] = c; ropes[e] = s;
  }
  f16* mu16 = (f16*)(p.ws + OFF_MU16);
  if (gt < 6144) mu16[gt] = (f16)p.in(15)[gt];
  for (int it = bid; it < 192; it += G) mod_item(p, it, smem);
  int base = 192;
  conv_job(p.in(10), 1024, 1536, (f16*)(p.ws + A_WQKV), 1024, base, smem);
  conv_job(p.in(14), 1024, 1024, (f16*)(p.ws + A_WO0), 1024, base, smem);
  conv_job(p.in(8), 1024, 4096, (f16*)(p.ws + A_W1_0), 1024, base, smem);
  conv_job(p.in(9), 4096, 1024, (f16*)(p.ws + A_W2_0), 4096, base, smem);
  for (int d = 0; d < 2; ++d) conv_job(p.in(19) + (size_t)d * 64 * 1024, 64, 1024, (f16*)(p.ws + OFF_W2DEC) + (size_t)d * 1024 * 64, 64, base, smem);
  conv_job(p.in(22), 64, 1024, (f16*)(p.ws + OFF_A2), 64, base, smem);
  for (int d = 0; d < 2; ++d) conv_job(p.in(24) + (size_t)d * 128 * 1024, 128, 1024, (f16*)(p.ws + OFF_G2) + (size_t)d * 1024 * 128, 128, base, smem);
  conv_job(p.in(30), 1024, 1024, (f16*)(p.ws + OFF_WO1), 1024, base, smem);
}

DI void phase_norm(const float* srcLat, const float* srcCtx, const float* g, const float* modl, int shidx, f16* dst, int ntok) {
  const int tid = vtid(), lane = tid & 63, wave = tid >> 6;
  for (int t4 = vbid(); t4 < (ntok >> 2); t4 += vgrid()) {
    const int tok = t4 * 4 + wave;
    const float* src = tok < T_LAT ? srcLat + (size_t)tok * 1024 : srcCtx + (size_t)(tok - T_LAT) * 1024;
    const int bi = tok < T_LAT ? (tok >> 13) : 4;
    const float* sh = modl + bi * 6144 + shidx * 1024;
    const float* sc = sh + 1024;
    float4 v[4];
    float ss = 0.f;
#pragma unroll
    for (int q = 0; q < 4; ++q) {
      v[q] = ((const float4*)src)[lane + 64 * q];
      ss += v[q].x * v[q].x + v[q].y * v[q].y + v[q].z * v[q].z + v[q].w * v[q].w;
    }
    ss = wave_sum(ss, lane);
    const float rs = rsqrtf(ss * (1.f / 1024.f) + 1e-6f);
#pragma unroll
    for (int q = 0; q < 4; ++q) {
      const int col = (lane + 64 * q) * 4;
      float4 g4 = *(const float4*)(g + col), s4 = *(const float4*)(sc + col), h4 = *(const float4*)(sh + col);
      float y0 = v[q].x * rs * g4.x * (1.f + s4.x) + h4.x;
      float y1 = v[q].y * rs * g4.y * (1.f + s4.y) + h4.y;
      float y2 = v[q].z * rs * g4.z * (1.f + s4.z) + h4.z;
      float y3 = v[q].w * rs * g4.w * (1.f + s4.w) + h4.w;
      *(uint2*)(dst + (size_t)tok * 1024 + col) = make_uint2(pack_h2(y0, y1), pack_h2(y2, y3));
    }
  }
}

DI void phase_shift(const PA& p, unsigned char* smem) {
  const int tid = vtid(), lane = tid & 63, wave = tid >> 6;
  float* red = (float*)smem;
  const float* modl = (const float*)(p.ws + OFF_MOD) + 5 * 6144;
  const float* g = p.in(6) + 1024;
  const float* xc = (const float*)(p.ws + OFF_XC);
  f16* H = (f16*)(p.ws + A_H);
  f16* XX = (f16*)(p.ws + A_XX);
  const int col = tid * 4;
  for (int ch = vbid(); ch < T_ALL / 8; ch += vgrid()) {
    const int t0 = ch * 8;
    int lo, hi, bi;
    if (t0 < T_LAT) { lo = (t0 >> 13) << 13; hi = lo + 8192; bi = t0 >> 13; }
    else { lo = T_LAT + (((t0 - T_LAT) >> 8) << 8); hi = lo + 256; bi = 4; }
    float4 x[10];
    float ss[10];
#pragma unroll
    for (int i = 0; i < 10; ++i) {
      const int tok = t0 - 1 + i;
      const bool ok = tok >= lo && tok < hi;
      if (ok) {
        const float* src = tok < T_LAT ? p.out + (size_t)tok * 1024 : xc + (size_t)(tok - T_LAT) * 1024;
        x[i] = *(const float4*)(src + col);
      } else x[i] = make_float4(0.f, 0.f, 0.f, 0.f);
      ss[i] = wave_sum(x[i].x * x[i].x + x[i].y * x[i].y + x[i].z * x[i].z + x[i].w * x[i].w, lane);
    }
    if (lane == 0) {
#pragma unroll
      for (int i = 0; i < 10; ++i) red[wave * 10 + i] = ss[i];
    }
    __syncthreads();
    const float* sh = modl + bi * 6144;
    float4 g4 = *(const float4*)(g + col), s4 = *(const float4*)(sh + 1024 + col), h4 = *(const float4*)(sh + col);
#pragma unroll
    for (int i = 0; i < 10; ++i) {
      const int tok = t0 - 1 + i;
      const bool ok = tok >= lo && tok < hi;
      const float tot = red[i] + red[10 + i] + red[20 + i] + red[30 + i];
      const float rs = rsqrtf(tot * (1.f / 1024.f) + 1e-6f);
      if (ok) {
        x[i].x = x[i].x * rs * g4.x * (1.f + s4.x) + h4.x;
        x[i].y = x[i].y * rs * g4.y * (1.f + s4.y) + h4.y;
        x[i].z = x[i].z * rs * g4.z * (1.f + s4.z) + h4.z;
        x[i].w = x[i].w * rs * g4.w * (1.f + s4.w) + h4.w;
      }
    }
#pragma unroll
    for (int i = 1; i <= 8; ++i) {
      const int tok = t0 - 1 + i;
      float a0 = 0.5f * (x[i - 1].x + x[i + 1].x) - x[i].x;
      float a1 = 0.5f * (x[i - 1].y + x[i + 1].y) - x[i].y;
      float a2 = 0.5f * (x[i - 1].z + x[i + 1].z) - x[i].z;
      float a3 = 0.5f * (x[i - 1].w + x[i + 1].w) - x[i].w;
      *(uint2*)(H + (size_t)tok * 1024 + col) = make_uint2(pack_h2(x[i].x, x[i].y), pack_h2(x[i].z, x[i].w));
      *(uint2*)(XX + (size_t)tok * 1024 + col) = make_uint2(pack_h2(a0, a1), pack_h2(a2, a3));
    }
    __syncthreads();
  }
}

DI uint4 hfma8(uint4 x, uint4 m, uint4 a) {
  uint4 r;
  r.x = __builtin_bit_cast(unsigned, (f16x2)(__builtin_bit_cast(f16x2, x.x) * __builtin_bit_cast(f16x2, m.x) + __builtin_bit_cast(f16x2, a.x)));
  r.y = __builtin_bit_cast(unsigned, (f16x2)(__builtin_bit_cast(f16x2, x.y) * __builtin_bit_cast(f16x2, m.y) + __builtin_bit_cast(f16x2, a.y)));
  r.z = __builtin_bit_cast(unsigned, (f16x2)(__builtin_bit_cast(f16x2, x.z) * __builtin_bit_cast(f16x2, m.z) + __builtin_bit_cast(f16x2, a.z)));
  r.w = __builtin_bit_cast(unsigned, (f16x2)(__builtin_bit_cast(f16x2, x.w) * __builtin_bit_cast(f16x2, m.w) + __builtin_bit_cast(f16x2, a.w)));
  return r;
}

template <bool MIX>
DI void gemm_mainloop(f32x4 (&acc)[4][4], const f16* __restrict__ A, int lda, const f16* __restrict__ XXp, const f16* __restrict__ mu,
                      const f16* __restrict__ Bt, int ldb, int K, unsigned char* smem) {
  const int tid = vtid(), lane = tid & 63, wave = tid >> 6;
  const int wm = wave >> 1, wn = wave & 1;
  const int lr = tid >> 3, lc = (tid & 7) * 8;
  f16* sA = (f16*)smem;
  f16* sB = sA + 2 * 128 * 72;
#pragma unroll
  for (int i = 0; i < 4; ++i)
#pragma unroll
    for (int j = 0; j < 4; ++j) acc[i][j] = (f32x4){0.f, 0.f, 0.f, 0.f};
  uint4 ra0, ra1, ra2, ra3, rb0, rb1, rb2, rb3;
  const f16* Ap = A + (size_t)lr * lda + lc;
  const f16* Xp = MIX ? XXp + (size_t)lr * lda + lc : nullptr;
  const f16* Bp = Bt + (size_t)lr * ldb + lc;
#define GL1(RA, RB, P, K0)                                                         \
  {                                                                                \
    uint4 a_ = *(const uint4*)(Ap + (size_t)(32 * (P)) * lda + (K0));              \
    if (MIX) {                                                                     \
      uint4 x_ = *(const uint4*)(Xp + (size_t)(32 * (P)) * lda + (K0));            \
      uint4 m_ = *(const uint4*)(mu + (K0) + lc);                                  \
      a_ = hfma8(x_, m_, a_);                                                      \
    }                                                                              \
    RA = a_;                                                                       \
    RB = *(const uint4*)(Bp + (size_t)(32 * (P)) * ldb + (K0));                    \
  }
#define gload(K0) { GL1(ra0, rb0, 0, K0) GL1(ra1, rb1, 1, K0) GL1(ra2, rb2, 2, K0) GL1(ra3, rb3, 3, K0) }
#define SW1(RA, RB, P, BUF)                                                        \
  {                                                                                \
    *(uint4*)(sA + ((BUF) * 128 + lr + 32 * (P)) * 72 + lc) = RA;                  \
    *(uint4*)(sB + ((BUF) * 128 + lr + 32 * (P)) * 72 + lc) = RB;                  \
  }
#define swrite(BUF) { SW1(ra0, rb0, 0, BUF) SW1(ra1, rb1, 1, BUF) SW1(ra2, rb2, 2, BUF) SW1(ra3, rb3, 3, BUF) }
  gload(0);
  swrite(0);
  __syncthreads();
  const int nk = K >> 6;
  for (int kt = 0; kt < nk; ++kt) {
    const int cur = kt & 1;
    if (kt + 1 < nk) gload((kt + 1) * 64);
    const f16* a_base = sA + (cur * 128 + wm * 64 + (lane & 15)) * 72 + (lane >> 4) * 8;
    const f16* b_base = sB + (cur * 128 + wn * 64 + (lane & 15)) * 72 + (lane >> 4) * 8;
#pragma unroll
    for (int ks = 0; ks < 2; ++ks) {
      f16x8 af[4], bfr[4];
#pragma unroll
      for (int mt = 0; mt < 4; ++mt) af[mt] = *(const f16x8*)(a_base + mt * 16 * 72 + ks * 32);
#pragma unroll
      for (int nt = 0; nt < 4; ++nt) bfr[nt] = *(const f16x8*)(b_base + nt * 16 * 72 + ks * 32);
#pragma unroll
      for (int mt = 0; mt < 4; ++mt)
#pragma unroll
        for (int nt = 0; nt < 4; ++nt) acc[mt][nt] = __builtin_amdgcn_mfma_f32_16x16x32_f16(af[mt], bfr[nt], acc[mt][nt], 0, 0, 0);
    }
    if (kt + 1 < nk) swrite(cur ^ 1);
    __syncthreads();
  }
}

#undef gload
#undef swrite
#undef GL1
#undef SW1

DI void stage_c(const f32x4 (&acc)[4][4], unsigned char* smem) {
  float* sC = (float*)smem;
  const int tid = vtid(), lane = tid & 63, wave = tid >> 6;
  const int wm = wave >> 1, wn = wave & 1, g = lane >> 4, c = lane & 15;
#pragma unroll
  for (int mt = 0; mt < 4; ++mt)
#pragma unroll
    for (int nt = 0; nt < 4; ++nt)
#pragma unroll
      for (int i = 0; i < 4; ++i) sC[(wm * 64 + mt * 16 + g * 4 + i) * 132 + wn * 64 + nt * 16 + c] = acc[mt][nt][i];
  __syncthreads();
}

DI void epi_qkv(const PA& p, int m, int n, const float* cr, int row, int half) {
  const int tok = m * 128 + row, hd = n * 2 + half;
  if (hd < 20) {
    const float* gain = hd < 16 ? p.in(11) : p.in(12);
    float ss = 0.f;
#pragma unroll
    for (int c4 = 0; c4 < 16; ++c4) {
      float4 t = *(const float4*)(cr + c4 * 4);
      ss += t.x * t.x + t.y * t.y + t.z * t.z + t.w * t.w;
    }
    const float rs = rsqrtf(ss * (1.f / 64.f) + 1e-6f);
    const bool lat = tok < T_LAT;
    const int s = tok & 8191;
    const float* ropec = (const float*)(p.ws + OFF_ROPE);
    const float* ropes = ropec + 2048;
    f16* dst = hd < 16 ? (f16*)(p.ws + A_Q) + (size_t)tok * 1024 + hd * 64 : (f16*)(p.ws + A_K) + (size_t)tok * 256 + (hd - 16) * 64;
#pragma unroll
    for (int hh = 0; hh < 2; ++hh) {
      const int pos = hh ? (s & 63) : (s >> 6);
#pragma unroll
      for (int j4 = 0; j4 < 4; ++j4) {
        const int c0 = hh * 32 + j4 * 4;
        float4 t1 = *(const float4*)(cr + c0), t2 = *(const float4*)(cr + c0 + 16);
        float4 g1 = *(const float4*)(gain + c0), g2 = *(const float4*)(gain + c0 + 16);
        t1.x *= rs * g1.x; t1.y *= rs * g1.y; t1.z *= rs * g1.z; t1.w *= rs * g1.w;
        t2.x *= rs * g2.x; t2.y *= rs * g2.y; t2.z *= rs * g2.z; t2.w *= rs * g2.w;
        float4 o1 = t1, o2 = t2;
        if (lat) {
          float4 cc = *(const float4*)(ropec + pos * 16 + j4 * 4), sn = *(const float4*)(ropes + pos * 16 + j4 * 4);
          o1.x = t1.x * cc.x - t2.x * sn.x; o2.x = t1.x * sn.x + t2.x * cc.x;
          o1.y = t1.y * cc.y - t2.y * sn.y; o2.y = t1.y * sn.y + t2.y * cc.y;
          o1.z = t1.z * cc.z - t2.z * sn.z; o2.z = t1.z * sn.z + t2.z * cc.z;
          o1.w = t1.w * cc.w - t2.w * sn.w; o2.w = t1.w * sn.w + t2.w * cc.w;
        }
        *(uint2*)(dst + c0) = make_uint2(pack_h2(o1.x, o1.y), pack_h2(o1.z, o1.w));
        *(uint2*)(dst + c0 + 16) = make_uint2(pack_h2(o2.x, o2.y), pack_h2(o2.z, o2.w));
      }
    }
  } else {
    const int kvh = hd - 20;
    int b, tpos;
    if (tok < T_LAT) { b = tok >> 13; tpos = tok & 8191; } else { b = (tok - T_LAT) >> 8; tpos = 8192 + ((tok - T_LAT) & 255); }
    u16* base = (u16*)(p.ws + A_VT) + (size_t)((b * 4 + kvh) * 64) * 8448 + tpos;
#pragma unroll 8
    for (int c = 0; c < 64; ++c) base[(size_t)c * 8448] = __builtin_bit_cast(u16, (f16)cr[c]);
  }
}

DI void epi_res(const GemmArgs& ga, int m, int n, const float* cr, int row, int half) {
  const int tok = m * 128 + row, col0 = n * 128 + half * 64;
  const float* src; float* dst; int bi;
  if (tok < T_LAT) { src = ga.srcLat + (size_t)tok * 1024; dst = ga.dstLat + (size_t)tok * 1024; bi = tok >> 13; }
  else { src = ga.srcCtx + (size_t)(tok - T_LAT) * 1024; dst = ga.dstCtx + (size_t)(tok - T_LAT) * 1024; bi = 4; }
  const float* gt = ga.gt + bi * 6144;
#pragma unroll 4
  for (int c4 = 0; c4 < 16; ++c4) {
    float4 a = *(const float4*)(cr + c4 * 4);
    float4 x = *(const float4*)(src + col0 + c4 * 4);
    float4 g = *(const float4*)(gt + col0 + c4 * 4);
    float4 o = make_float4(x.x + g.x * a.x, x.y + g.y * a.y, x.z + g.z * a.z, x.w + g.w * a.w);
    *(float4*)(dst + col0 + c4 * 4) = o;
  }
}

DI void epi_mlp1(const GemmArgs& ga, int m, int n, const float* cr, int row, int half) {
  const int tok = m * 128 + row, col0 = n * 128 + half * 64;
  f16* dst = ga.dstH + (size_t)tok * 4096 + col0;
#pragma unroll 2
  for (int q = 0; q < 8; ++q) {
    float4 a = *(const float4*)(cr + q * 8), b = *(const float4*)(cr + q * 8 + 4);
    a.x = fmaxf(a.x, 0.f); a.y = fmaxf(a.y, 0.f); a.z = fmaxf(a.z, 0.f); a.w = fmaxf(a.w, 0.f);
    b.x = fmaxf(b.x, 0.f); b.y = fmaxf(b.y, 0.f); b.z = fmaxf(b.z, 0.f); b.w = fmaxf(b.w, 0.f);
    *(uint4*)(dst + q * 8) = make_uint4(pack_h2(a.x * a.x, a.y * a.y), pack_h2(a.z * a.z, a.w * a.w),
                                        pack_h2(b.x * b.x, b.y * b.y), pack_h2(b.z * b.z, b.w * b.w));
  }
}

DI void epi_b2(const PA& p, int m, int n, const float* cr, int row, int half) {
  const int tok = m * 128 + row, head = n * 2 + half, ch0 = head * 64;
  f16* Kp = (f16*)(p.ws + A_KP) + (size_t)tok * 1024 + ch0;
  const f16* Rp = (const f16*)(p.ws + A_R) + (size_t)tok * 1024 + ch0;
  f16* KK = (f16*)(p.ws + A_KKN) + (size_t)tok * 1024 + ch0;
  f16* BV = (f16*)(p.ws + A_BV) + (size_t)tok * 1024 + ch0;
  const float* k_k = p.in(25) + ch0; const float* k_a = p.in(26) + ch0; const float* r_k = p.in(27) + ch0; const float* a0 = p.in(20) + ch0;
  f16x8 kv[8];
  float ss = 0.f;
#pragma unroll
  for (int q = 0; q < 8; ++q) {
    kv[q] = *(const f16x8*)(Kp + q * 8);
#pragma unroll
    for (int e = 0; e < 8; ++e) { float t = (float)kv[q][e] * k_k[q * 8 + e]; ss += t * t; }
  }
  const float inv = 1.f / fmaxf(sqrtf(ss), 1e-12f);
  float rk = 0.f;
#pragma unroll
  for (int q = 0; q < 8; ++q) {
    f16x8 rv = *(const f16x8*)(Rp + q * 8);
    float kk[8], bv[8], kp[8];
#pragma unroll
    for (int e = 0; e < 8; ++e) {
      const int c = q * 8 + e;
      const float kr = (float)kv[q][e];
      const float al = sigmoidf_(a0[c] + cr[c]);
      kk[e] = kr * k_k[c] * inv;
      bv[e] = kk[e] * al;
      kp[e] = kr * (1.f + (al - 1.f) * k_a[c]);
      rk += (float)rv[e] * kp[e] * r_k[c];
    }
    *(uint4*)(KK + q * 8) = make_uint4(pack_h2(kk[0], kk[1]), pack_h2(kk[2], kk[3]), pack_h2(kk[4], kk[5]), pack_h2(kk[6], kk[7]));
    *(uint4*)(BV + q * 8) = make_uint4(pack_h2(bv[0], bv[1]), pack_h2(bv[2], bv[3]), pack_h2(bv[4], bv[5]), pack_h2(bv[6], bv[7]));
    *(uint4*)(Kp + q * 8) = make_uint4(pack_h2(kp[0], kp[1]), pack_h2(kp[2], kp[3]), pack_h2(kp[4], kp[5]), pack_h2(kp[6], kp[7]));
  }
  ((float*)(p.ws + OFF_RK))[(size_t)tok * 16 + head] = rk;
}

DI void epi_feat(const PA& p, int m, int n, const float* cr, int row, int half) {
  const int tok = m * 128 + row;
  size_t off; int mode;
  if (n < 24) { off = (n < 8 ? A_R : (n < 16 ? A_KP : A_V)) + ((size_t)tok * 1024 + (n & 7) * 128 + half * 64) * 2; mode = 0; }
  else if (n == 24) { off = A_TW + ((size_t)tok * 128 + half * 64) * 2; mode = 1; }
  else if (n == 25) { off = A_AI + ((size_t)tok * 64) * 2; mode = half == 0 ? 0 : 3; }
  else { off = A_G + ((size_t)tok * 256 + (n - 26) * 128 + half * 64) * 2; mode = 2; }
  if (mode == 3) return;
  f16* dst = (f16*)(p.ws + off);
#pragma unroll 2
  for (int q = 0; q < 8; ++q) {
    float4 a = *(const float4*)(cr + q * 8), b = *(const float4*)(cr + q * 8 + 4);
    if (mode == 1) {
      a.x = tanhf_(a.x); a.y = tanhf_(a.y); a.z = tanhf_(a.z); a.w = tanhf_(a.w);
      b.x = tanhf_(b.x); b.y = tanhf_(b.y); b.z = tanhf_(b.z); b.w = tanhf_(b.w);
    } else if (mode == 2) {
      a.x = sigmoidf_(a.x); a.y = sigmoidf_(a.y); a.z = sigmoidf_(a.z); a.w = sigmoidf_(a.w);
      b.x = sigmoidf_(b.x); b.y = sigmoidf_(b.y); b.z = sigmoidf_(b.z); b.w = sigmoidf_(b.w);
    }
    *(uint4*)(dst + q * 8) = make_uint4(pack_h2(a.x, a.y), pack_h2(a.z, a.w), pack_h2(b.x, b.y), pack_h2(b.z, b.w));
  }
}

template <int EPI>
DI void gemm_phase(const PA& p, const GemmArgs& ga, unsigned char* smem, int m0 = 0, const f16* XXp = nullptr, const f16* mu16 = nullptr) {
  const int tid = vtid(), row = tid >> 1, half = tid & 1;
  const float* cr = (const float*)smem + row * 132 + half * 64;
  const int ntile = ga.MT * ga.NT;
  for (int t = vbid(); t < ntile; t += vgrid()) {
    const int mi = t / ga.NT, n = t - mi * ga.NT, m = m0 + mi;
    f32x4 acc[4][4];
    if (EPI == EPI_FEAT) {
      const int mx = n < 8 ? 0 : (n < 16 ? 2 : (n < 24 ? 3 : (n == 24 ? 1 : (n == 25 ? 4 : 5))));
      gemm_mainloop<true>(acc, ga.A + (size_t)m * 128 * ga.lda, ga.lda, XXp + (size_t)m * 128 * ga.lda, mu16 + mx * 1024, ga.Bt + (size_t)n * 128 * ga.ldb, ga.ldb, ga.K, smem);
    } else {
      gemm_mainloop<false>(acc, ga.A + (size_t)m * 128 * ga.lda, ga.lda, nullptr, nullptr, ga.Bt + (size_t)n * 128 * ga.ldb, ga.ldb, ga.K, smem);
    }
    stage_c(acc, smem);
    if (EPI == EPI_QKV) epi_qkv(p, m, n, cr, row, half);
    else if (EPI == EPI_RES) epi_res(ga, m, n, cr, row, half);
    else if (EPI == EPI_MLP1) epi_mlp1(ga, m, n, cr, row, half);
    else if (EPI == EPI_FEAT) epi_feat(p, m, n, cr, row, half);
    else epi_b2(p, m, n, cr, row, half);
    __syncthreads();
  }
}

constexpr int G_HT = 128 * 64;
DI int lds_byte(int r, int c) {
  int st = (r >> 4) * 2 + (c >> 5), rr = r & 15, cc = c & 31, ob = rr * 64 + cc * 2;
  return st * 1024 + (ob ^ (((ob >> 9) & 1) << 5));
}
DI void stage_rc(int b, int& R, int& C) {
  int st = b / 1024, sb = b % 1024, swz = sb ^ (((sb >> 9) & 1) << 5);
  R = (st >> 1) * 16 + swz / 64; C = (st & 1) * 32 + (swz % 64) / 2;
}
DI int perm32(int rho) { const int n = rho >> 4, i = rho & 15; return 8 * (i >> 2) + 4 * n + (i & 3); }
DI bool unit_next(int i, int G, int c, int nM, int nN, int& pm, int& pn) {
  const int nwg = nM * nN;
  const long L = (long)i * G + c;
  if (L >= nwg) return false;
  int wgid = (int)L;
  { const int q = nwg / 8, r = nwg % 8, xcd = wgid % 8, off = wgid / 8; wgid = (xcd < r ? xcd * (q + 1) : r * (q + 1) + (xcd - r) * q) + off; }
  const int nig = 8 * nN, gid = wgid / nig, fm = gid * 8, gsz = (nM - fm) < 8 ? (nM - fm) : 8;
  pm = fm + ((wgid % nig) % gsz); pn = (wgid % nig) / gsz;
  return true;
}
struct BigArgs {
  const f16* A1; const f16* A2; const f16* Bt; int lda, ldb, nk1, nt, nM, nN;
  GemmArgs e;
};

template <int EPI>
DI void gemm256_phase(const PA& p, const BigArgs& ga, unsigned char* smem) {
  typedef __attribute__((address_space(3))) unsigned char* LdsP;
  LdsP lds = (LdsP)smem;
  const int tid = opaque_tid();
  const int wid = __builtin_amdgcn_readfirstlane(tid >> 6), lane = tid & 63, wr = wid >> 2, wc = wid & 3, fr = lane & 15, fq = lane >> 4;
  const int lda = ga.lda, ldb = ga.ldb, nk1 = ga.nk1, nt = ga.nt;
  const int cid = __builtin_amdgcn_readfirstlane((int)*(volatile __attribute__((address_space(3))) unsigned*)(smem + 2 * LDS_HALF + 12));
  unsigned oa0, oa1, ob0, ob1;
  { int R, C; stage_rc(tid * 16, R, C); oa0 = (unsigned)(R * lda + C) * 2u; ob0 = (unsigned)(R * ldb + C) * 2u;
    stage_rc(tid * 16 + 8192, R, C); oa1 = (unsigned)(R * lda + C) * 2u; ob1 = (unsigned)(R * ldb + C) * 2u; }
  const unsigned ldsw = (unsigned)wid * 1024u;
  const int aoff = lds_byte(wr * 64 + fr, fq * 8), boff = lds_byte(wc * 32 + fr, fq * 8);
#define SA(b, h) (((b) * 2 + (h)) * 16384)
#define SB(b, h) ((4 + (b) * 2 + (h)) * 16384)
#define LDSU(x) ((__attribute__((address_space(3))) unsigned*)(x))
#define STAGE_A(P, br, kt)                                                                                             \
  do {                                                                                                                 \
    const char* base_ = (const char*)(ga.A1 + (long)(br) * lda + (long)(kt) * 64);          \
    __builtin_amdgcn_global_load_lds((const unsigned*)(base_ + oa0), LDSU(lds + (P) + ldsw), 16, 0, 0);                \
    __builtin_amdgcn_global_load_lds((const unsigned*)(base_ + oa1), LDSU(lds + (P) + ldsw + 8192), 16, 0, 0);         \
  } while (0)
#define STAGE_B(P, br, kt)                                                                                             \
  do {                                                                                                                 \
    const char* base_ = (const char*)(ga.Bt + (long)(br) * ldb + (long)(kt) * 64);                                     \
    __builtin_amdgcn_global_load_lds((const unsigned*)(base_ + ob0), LDSU(lds + (P) + ldsw), 16, 0, 0);                \
    __builtin_amdgcn_global_load_lds((const unsigned*)(base_ + ob1), LDSU(lds + (P) + ldsw + 8192), 16, 0, 0);         \
  } while (0)
#define LDA(dst, b, h)            \
  for (int m = 0; m < 4; ++m)     \
    for (int k = 0; k < 2; ++k) dst[m][k] = *(const __attribute__((address_space(3))) f16x8*)(lds + SA(b, h) + aoff + m * 2048 + k * 1024)
#define LDB(dst, b, h)            \
  for (int n = 0; n < 2; ++n)     \
    for (int k = 0; k < 2; ++k) dst[n][k] = *(const __attribute__((address_space(3))) f16x8*)(lds + SB(b, h) + boff + n * 2048 + k * 1024)
#define MMA(ai, bj, At_, Bt_)                                                                                          \
  do {                                                                                                                 \
    __builtin_amdgcn_s_setprio(1);                                                                                     \
    for (int m = 0; m < 4; ++m)                                                                                        \
      for (int n = 0; n < 2; ++n)                                                                                      \
        for (int k = 0; k < 2; ++k) acc[ai][bj][m][n] = __builtin_amdgcn_mfma_f32_16x16x32_f16(At_[m][k], Bt_[n][k], acc[ai][bj][m][n], 0, 0, 0); \
    __builtin_amdgcn_s_setprio(0);                                                                                     \
  } while (0)
#define WAIT_V(n) asm volatile("s_waitcnt vmcnt(" #n ")" ::: "memory")
#define WAIT_L(n) asm volatile("s_waitcnt lgkmcnt(" #n ")" ::: "memory")
#define BAR __builtin_amdgcn_s_barrier()
#define SCHED __builtin_amdgcn_sched_barrier(0)
  for (int ui = 0;; ++ui) {
    int pm, pn;
    if (!unit_next(ui, (int)gridDim.x, cid, ga.nM, ga.nN, pm, pn)) break;
    const int brow = pm * 256, bcol = pn * 256;
    f32x4 acc[2][2][4][2];
#pragma unroll
    for (int a = 0; a < 2; ++a)
#pragma unroll
      for (int b = 0; b < 2; ++b)
#pragma unroll
        for (int m = 0; m < 4; ++m)
#pragma unroll
          for (int n = 0; n < 2; ++n) acc[a][b][m][n] = (f32x4){0.f, 0.f, 0.f, 0.f};
    f16x8 At[4][2], B0[2][2], B1[2][2];
    STAGE_B(SB(0, 0), bcol, 0); STAGE_A(SA(0, 0), brow, 0);
    STAGE_B(SB(0, 1), bcol + 128, 0); STAGE_A(SA(0, 1), brow + 128, 0);
    if (wr == 1) BAR;
    WAIT_V(4); BAR;
    STAGE_B(SB(1, 0), bcol, 1); STAGE_A(SA(1, 0), brow, 1); STAGE_B(SB(1, 1), bcol + 128, 1);
    WAIT_V(6); BAR;
    for (int t = 0; t < nt - 2; t += 2) {
      LDB(B0, 0, 0); SCHED; LDA(At, 0, 0); STAGE_A(SA(1, 1), brow + 128, t + 1);
      WAIT_L(8); BAR; WAIT_L(0); MMA(0, 0, At, B0); BAR; SCHED;
      LDB(B1, 0, 1); STAGE_B(SB(0, 0), bcol, t + 2);
      BAR; WAIT_L(0); MMA(0, 1, At, B1); BAR;
      LDA(At, 0, 1); STAGE_A(SA(0, 0), brow, t + 2);
      BAR; WAIT_L(0); MMA(1, 0, At, B0); BAR; SCHED;
      STAGE_B(SB(0, 1), bcol + 128, t + 2);
      WAIT_V(6); BAR; MMA(1, 1, At, B1); BAR;
      LDB(B0, 1, 0); SCHED; LDA(At, 1, 0); STAGE_A(SA(0, 1), brow + 128, t + 2);
      WAIT_L(8); BAR; WAIT_L(0); MMA(0, 0, At, B0); BAR; SCHED;
      LDB(B1, 1, 1); STAGE_B(SB(1, 0), bcol, t + 3);
      BAR; WAIT_L(0); MMA(0, 1, At, B1); BAR;
      LDA(At, 1, 1); STAGE_A(SA(1, 0), brow, t + 3);
      BAR; WAIT_L(0); MMA(1, 0, At, B0); BAR; SCHED;
      STAGE_B(SB(1, 1), bcol + 128, t + 3);
      WAIT_V(6); BAR; MMA(1, 1, At, B1); BAR;
    }
    { LDB(B0, 0, 0); LDA(At, 0, 0); STAGE_A(SA(1, 1), brow + 128, nt - 1);
      BAR; WAIT_L(0); MMA(0, 0, At, B0); BAR;
      LDB(B1, 0, 1); BAR; WAIT_L(0); MMA(0, 1, At, B1); BAR;
      LDA(At, 0, 1); WAIT_V(4); BAR; WAIT_L(0); MMA(1, 0, At, B0); MMA(1, 1, At, B1); BAR; }
    { LDB(B0, 1, 0); LDA(At, 1, 0); WAIT_V(2); BAR; WAIT_L(0); MMA(0, 0, At, B0); BAR;
      LDB(B1, 1, 1); WAIT_V(0); BAR; WAIT_L(0); MMA(0, 1, At, B1); BAR;
      LDA(At, 1, 1); BAR; WAIT_L(0); MMA(1, 0, At, B0); MMA(1, 1, At, B1); BAR; }
    if (wr == 0) BAR;
    __syncthreads();
    float* sC = (float*)smem;
    const int tid2 = opaque_tid();
    const int vb = tid2 >> 8, vt = tid2 & 255, erow = vt >> 1, ehalf = vt & 1;
    const int sc_base = (wr * 64 + ((tid2 & 63) >> 4) * 4) * 132 + wc * 32 + (tid2 & 15);
    const float* cr = sC + vb * (128 * 132) + erow * 132 + ehalf * 64;
#pragma unroll
    for (int ai = 0; ai < 2; ++ai) {
#pragma unroll
      for (int bj = 0; bj < 2; ++bj)
#pragma unroll
        for (int m = 0; m < 4; ++m)
#pragma unroll
          for (int n = 0; n < 2; ++n)
#pragma unroll
            for (int j = 0; j < 4; ++j) sC[sc_base + bj * (128 * 132) + (m * 16 + j) * 132 + n * 16] = acc[ai][bj][m][n][j];
      __syncthreads();
      const int em = pm * 2 + ai, en = pn * 2 + vb;
      if (EPI == EPI_QKV) epi_qkv(p, em, en, cr, erow, ehalf);
      else if (EPI == EPI_RES) epi_res(ga.e, em, en, cr, erow, ehalf);
      else if (EPI == EPI_MLP1) epi_mlp1(ga.e, em, en, cr, erow, ehalf);
      else epi_feat(p, em, en, cr, erow, ehalf);
      __syncthreads();
    }
  }
#undef SA
#undef SB
#undef LDSU
#undef STAGE_A
#undef STAGE_B
#undef LDA
#undef LDB
#undef MMA
}

template <int EPI>
DI void epi_direct(const PA& p, const BigArgs& ga, const f32x4 (&acc)[2][2][4][2], int pm, int pn, int wr, int wc, int fr, int fq) {
  const int row0 = pm * 256 + wr * 64 + fr, col0 = pn * 256 + wc * 32 + fq * 8;
  if (EPI == EPI_MLP1) {
    f16* U = ga.e.dstH;
#pragma unroll
    for (int ai = 0; ai < 2; ++ai)
#pragma unroll
      for (int m = 0; m < 4; ++m) {
        f16* rp = U + (size_t)(row0 + ai * 128 + m * 16) * 4096 + col0;
#pragma unroll
        for (int bj = 0; bj < 2; ++bj) {
          const f32x4 v0 = acc[ai][bj][m][0], v1 = acc[ai][bj][m][1];
          const float a0 = fmaxf(v0[0], 0.f), a1 = fmaxf(v0[1], 0.f), a2 = fmaxf(v0[2], 0.f), a3 = fmaxf(v0[3], 0.f);
          const float b0 = fmaxf(v1[0], 0.f), b1 = fmaxf(v1[1], 0.f), b2 = fmaxf(v1[2], 0.f), b3 = fmaxf(v1[3], 0.f);
          typedef unsigned u32x4_t __attribute__((ext_vector_type(4)));
          const u32x4_t pk_ = {pack_h2(a0 * a0, a1 * a1), pack_h2(a2 * a2, a3 * a3), pack_h2(b0 * b0, b1 * b1), pack_h2(b2 * b2, b3 * b3)};
          __builtin_nontemporal_store(pk_, (u32x4_t*)(rp + bj * 128));
        }
      }
  } else if (EPI == EPI_RES) {
    const bool lat = pm < 128;
    const float* src = lat ? ga.e.srcLat : ga.e.srcCtx;
    float* dst = lat ? ga.e.dstLat : ga.e.dstCtx;
    const int rbase = lat ? row0 : row0 - T_LAT;
    const float* gt = ga.e.gt + (lat ? (pm >> 5) : 4) * 6144 + col0;
#pragma unroll
    for (int bj = 0; bj < 2; ++bj) {
      const f32x4 g0 = *(const f32x4*)(gt + bj * 128), g1 = *(const f32x4*)(gt + bj * 128 + 4);
#pragma unroll
      for (int ai = 0; ai < 2; ++ai)
#pragma unroll
        for (int m = 0; m < 4; ++m) {
          const size_t o = (size_t)(rbase + ai * 128 + m * 16) * 1024 + col0 + bj * 128;
          const f32x4 x0 = *(const f32x4*)(src + o), x1 = *(const f32x4*)(src + o + 4);
          *(f32x4*)(dst + o) = x0 + g0 * acc[ai][bj][m][0];
          *(f32x4*)(dst + o + 4) = x1 + g1 * acc[ai][bj][m][1];
        }
    }
  } else {
#pragma unroll
    for (int bj = 0; bj < 2; ++bj) {
      const int n128 = pn * 2 + bj;
      unsigned base; int ld, mode;
      if (n128 < 24) { base = (n128 < 8 ? A_R : (n128 < 16 ? A_KP : A_V)) + (unsigned)((n128 & 7) * 128) * 2u; ld = 1024; mode = 0; }
      else if (n128 == 24) { base = A_TW; ld = 128; mode = 1; }
      else if (n128 == 25) { base = A_AI; ld = 64; mode = 0; }
      else { base = A_G + (unsigned)((n128 - 26) * 128) * 2u; ld = 256; mode = 2; }
      if (n128 == 25 && wc >= 2) continue;
      f16* dp = (f16*)(p.ws + base) + wc * 32 + fq * 8;
#pragma unroll
      for (int ai = 0; ai < 2; ++ai)
#pragma unroll
        for (int m = 0; m < 4; ++m) {
          f32x4 v0 = acc[ai][bj][m][0], v1 = acc[ai][bj][m][1];
          if (mode == 1) {
            v0[0] = tanhf_(v0[0]); v0[1] = tanhf_(v0[1]); v0[2] = tanhf_(v0[2]); v0[3] = tanhf_(v0[3]);
            v1[0] = tanhf_(v1[0]); v1[1] = tanhf_(v1[1]); v1[2] = tanhf_(v1[2]); v1[3] = tanhf_(v1[3]);
          } else if (mode == 2) {
            v0[0] = sigmoidf_(v0[0]); v0[1] = sigmoidf_(v0[1]); v0[2] = sigmoidf_(v0[2]); v0[3] = sigmoidf_(v0[3]);
            v1[0] = sigmoidf_(v1[0]); v1[1] = sigmoidf_(v1[1]); v1[2] = sigmoidf_(v1[2]); v1[3] = sigmoidf_(v1[3]);
          }
          *(uint4*)(dp + (size_t)(row0 + ai * 128 + m * 16) * ld) = make_uint4(pack_h2(v0[0], v0[1]), pack_h2(v0[2], v0[3]), pack_h2(v1[0], v1[1]), pack_h2(v1[2], v1[3]));
        }
    }
  }
}

template <int EPI>
DI void gemm256s_phase(const PA& p, const BigArgs& ga, unsigned char* smem) {
  typedef __attribute__((address_space(3))) unsigned char* LdsP;
  LdsP lds = (LdsP)smem;
  const int tid = opaque_tid();
  const int wid = __builtin_amdgcn_readfirstlane(tid >> 6), lane = tid & 63, wr = wid >> 2, wc = wid & 3, fr = lane & 15, fq = lane >> 4;
  const int lda = ga.lda, ldb = ga.ldb, nk1 = ga.nk1, nt = ga.nt;
  const int cid = __builtin_amdgcn_readfirstlane((int)*(volatile __attribute__((address_space(3))) unsigned*)(smem + 2 * LDS_HALF + 12));
  unsigned oa0, oa1, ob0, ob1;
  { int R, C; stage_rc(tid * 16, R, C); oa0 = (unsigned)(R * lda + C) * 2u; ob0 = (unsigned)(((R & ~31) + perm32(R & 31)) * ldb + C) * 2u;
    stage_rc(tid * 16 + 8192, R, C); oa1 = (unsigned)(R * lda + C) * 2u; ob1 = (unsigned)(((R & ~31) + perm32(R & 31)) * ldb + C) * 2u; }
  const unsigned ldsw = (unsigned)wid * 1024u;
  const int aoff = lds_byte(wr * 64 + fr, fq * 8), boff = lds_byte(wc * 32 + fr, fq * 8);
  const size_t hstepA = (size_t)128 * lda * 2, hstepB = (size_t)128 * ldb * 2;
#define SA(b, h) (((b) * 2 + (h)) * 16384)
#define SB(b, h) ((4 + (b) * 2 + (h)) * 16384)
#define LDSU(x) ((__attribute__((address_space(3))) unsigned*)(x))
#define UNIT_BASES(pm_, pn_, a1b, a2b, bb)                                                      \
  const char* a1b = (const char*)ga.A1 + (size_t)(pm_) * (2 * hstepA);                          \
  const char* a2b = (const char*)ga.A2 + (size_t)(pm_) * (2 * hstepA) - (size_t)nk1 * 128;      \
  const char* bb = (const char*)ga.Bt + (size_t)(pn_) * (2 * hstepB);
#define APTR(a1b, a2b, kt_) (((kt_) < nk1 ? (a1b) : (a2b)) + (size_t)(kt_) * 128)
#define BPTR(bb, kt_) ((bb) + (size_t)(kt_) * 128)
#define STAGE_A(P, base_)                                                                                    \
  do {                                                                                                       \
    __builtin_amdgcn_global_load_lds((const unsigned*)((base_) + oa0), LDSU(lds + (P) + ldsw), 16, 0, 0);    \
    __builtin_amdgcn_global_load_lds((const unsigned*)((base_) + oa1), LDSU(lds + (P) + ldsw + 8192), 16, 0, 0); \
  } while (0)
#define STAGE_B(P, base_)                                                                                    \
  do {                                                                                                       \
    __builtin_amdgcn_global_load_lds((const unsigned*)((base_) + ob0), LDSU(lds + (P) + ldsw), 16, 0, 0);    \
    __builtin_amdgcn_global_load_lds((const unsigned*)((base_) + ob1), LDSU(lds + (P) + ldsw + 8192), 16, 0, 0); \
  } while (0)
#define LDA(dst, b, h)            \
  for (int m = 0; m < 4; ++m)     \
    for (int k = 0; k < 2; ++k) dst[m][k] = *(const __attribute__((address_space(3))) f16x8*)(lds + SA(b, h) + aoff + m * 2048 + k * 1024)
#define LDB(dst, b, h)            \
  for (int n = 0; n < 2; ++n)     \
    for (int k = 0; k < 2; ++k) dst[n][k] = *(const __attribute__((address_space(3))) f16x8*)(lds + SB(b, h) + boff + n * 2048 + k * 1024)
#define MMA(ai, bj, At_, Bt_)                                                                                          \
  do {                                                                                                                 \
    __builtin_amdgcn_s_setprio(1);                                                                                     \
    for (int m = 0; m < 4; ++m)                                                                                        \
      for (int n = 0; n < 2; ++n)                                                                                      \
        for (int k = 0; k < 2; ++k) acc[ai][bj][m][n] = __builtin_amdgcn_mfma_f32_16x16x32_f16(Bt_[n][k], At_[m][k], acc[ai][bj][m][n], 0, 0, 0); \
    __builtin_amdgcn_s_setprio(0);                                                                                     \
  } while (0)
  int cpm, cpn, npm, npn, ui = 0;
  if (unit_next(0, (int)gridDim.x, cid, ga.nM, ga.nN, cpm, cpn)) {
    f32x4 acc[2][2][4][2];
#pragma unroll
    for (int a = 0; a < 2; ++a)
#pragma unroll
      for (int b = 0; b < 2; ++b)
#pragma unroll
        for (int m = 0; m < 4; ++m)
#pragma unroll
          for (int n = 0; n < 2; ++n) acc[a][b][m][n] = (f32x4){0.f, 0.f, 0.f, 0.f};
    f16x8 At[4][2], B0[2][2], B1[2][2];
    {
      UNIT_BASES(cpm, cpn, pa1, pa2, pb)
      STAGE_B(SB(0, 0), BPTR(pb, 0)); STAGE_A(SA(0, 0), APTR(pa1, pa2, 0)); STAGE_B(SB(0, 1), BPTR(pb, 0) + hstepB); STAGE_A(SA(0, 1), APTR(pa1, pa2, 0) + hstepA);
      if (wr == 1) BAR;
      WAIT_V(4); BAR;
      STAGE_B(SB(1, 0), BPTR(pb, 1)); STAGE_A(SA(1, 0), APTR(pa1, pa2, 1)); STAGE_B(SB(1, 1), BPTR(pb, 1) + hstepB);
      WAIT_V(6); BAR;
    }
    for (;;) {
      const bool has_next = unit_next(ui + 1, (int)gridDim.x, cid, ga.nM, ga.nN, npm, npn);
      const int xpm = has_next ? npm : cpm, xpn = has_next ? npn : cpn;
      UNIT_BASES(cpm, cpn, ca1, ca2, cb)
      UNIT_BASES(xpm, xpn, xa1, xa2, xb)
      for (int t = 0; t < nt; t += 2) {
        const bool last = (t == nt - 2);
        const char* a1 = APTR(ca1, ca2, t + 1);
        const char* a2 = last ? APTR(xa1, xa2, 0) : APTR(ca1, ca2, t + 2);
        const char* b2 = last ? BPTR(xb, 0) : BPTR(cb, t + 2);
        const char* a3 = last ? APTR(xa1, xa2, 1) : APTR(ca1, ca2, t + 3);
        const char* b3 = last ? BPTR(xb, 1) : BPTR(cb, t + 3);
        LDB(B0, 0, 0); SCHED; LDA(At, 0, 0); STAGE_A(SA(1, 1), a1 + hstepA);
        WAIT_L(8); BAR; WAIT_L(0); MMA(0, 0, At, B0); BAR; SCHED;
        LDB(B1, 0, 1); STAGE_B(SB(0, 0), b2);
        BAR; WAIT_L(0); MMA(0, 1, At, B1); BAR;
        LDA(At, 0, 1); STAGE_A(SA(0, 0), a2);
        BAR; WAIT_L(0); MMA(1, 0, At, B0); BAR; SCHED;
        STAGE_B(SB(0, 1), b2 + hstepB);
        WAIT_V(6); BAR; MMA(1, 1, At, B1); BAR;
        LDB(B0, 1, 0); SCHED; LDA(At, 1, 0); STAGE_A(SA(0, 1), a2 + hstepA);
        WAIT_L(8); BAR; WAIT_L(0); MMA(0, 0, At, B0); BAR; SCHED;
        LDB(B1, 1, 1); STAGE_B(SB(1, 0), b3);
        BAR; WAIT_L(0); MMA(0, 1, At, B1); BAR;
        LDA(At, 1, 1); STAGE_A(SA(1, 0), a3);
        BAR; WAIT_L(0); MMA(1, 0, At, B0); BAR; SCHED;
        STAGE_B(SB(1, 1), b3 + hstepB);
        WAIT_V(6); BAR; MMA(1, 1, At, B1); BAR;
      }
      epi_direct<EPI>(p, ga, acc, cpm, cpn, wr, wc, fr, fq);
      if (!has_next) break;
#pragma unroll
      for (int a = 0; a < 2; ++a)
#pragma unroll
        for (int b = 0; b < 2; ++b)
#pragma unroll
          for (int m = 0; m < 4; ++m)
#pragma unroll
            for (int n = 0; n < 2; ++n) acc[a][b][m][n] = (f32x4){0.f, 0.f, 0.f, 0.f};
      cpm = npm; cpn = npn; ++ui;
    }
    WAIT_V(0);
    if (wr == 0) BAR;
    BAR;
  }
#undef SA
#undef SB
#undef LDSU
#undef APTR
#undef BPTR
#undef UNIT_BASES
#undef STAGE_A
#undef STAGE_B
#undef LDA
#undef LDB
#undef MMA
}

DI void phase_attn(const PA& p, unsigned char* smem) {
  const int tid = vtid(), lane = tid & 63, wave = tid >> 6, g = lane >> 4, c16 = lane & 15;
  f16* sK = (f16*)smem;
  u16* sV = (u16*)(smem + 3 * 64 * 72 * 2);
  const f16* Q = (const f16*)(p.ws + A_Q);
  const f16* Kb = (const f16*)(p.ws + A_K);
  const u16* VT = (const u16*)(p.ws + A_VT);
  f16* O = (f16*)(p.ws + A_O);
  const int lr = tid >> 3, lc = (tid & 7) * 8;
  for (int u = vbid(); u < 4224; u += vgrid()) {
    int b, qb, head, isctx;
    if (u < 4096) { b = u >> 10; qb = (u >> 4) & 63; head = u & 15; isctx = 0; }
    else { int uu = u - 4096; b = uu >> 5; qb = (uu >> 4) & 1; head = uu & 15; isctx = 1; }
    const int kvh = head >> 2;
    const int qtok0 = isctx ? T_LAT + b * 256 + qb * 128 : b * 8192 + qb * 128;
    f16x8 qf[2][2];
#pragma unroll
    for (int nt = 0; nt < 2; ++nt)
#pragma unroll
      for (int ks = 0; ks < 2; ++ks)
        qf[nt][ks] = *(const f16x8*)(Q + (size_t)(qtok0 + wave * 32 + nt * 16 + c16) * 1024 + head * 64 + ks * 32 + g * 8) * (f16)0.18033688f;
    int w0 = 0, nw = 0;
    if (!isctx) { w0 = (qb == 0) ? 2 : 0; int w1 = (qb == 63) ? 3 : 5; nw = w1 - w0 + 1; }
    const int ntile = nw + 4;
    f32x4 oacc[4][2];
#pragma unroll
    for (int i = 0; i < 4; ++i)
#pragma unroll
      for (int j = 0; j < 2; ++j) oacc[i][j] = (f32x4){0.f, 0.f, 0.f, 0.f};
    uint4 rk0, rk1, rv0, rv1, sk0, sk1, sv0, sv1;
    const size_t vrow = (size_t)((b * 4 + kvh) * 64);
#define gload(TT, K0, K1, V0, V1)                                                                      \
  {                                                                                                    \
    const int t_ = (TT);                                                                               \
    int ktok0, tpos0;                                                                                  \
    if (t_ < nw) { int kp0 = (qb - 1) * 128 + (w0 + t_) * 64; ktok0 = b * 8192 + kp0; tpos0 = kp0; }    \
    else { int ct = t_ - nw; ktok0 = T_LAT + b * 256 + ct * 64; tpos0 = 8192 + ct * 64; }              \
    K0 = *(const uint4*)(Kb + (size_t)(ktok0 + lr) * 256 + kvh * 64 + lc);                             \
    K1 = *(const uint4*)(Kb + (size_t)(ktok0 + lr + 32) * 256 + kvh * 64 + lc);                        \
    V0 = *(const uint4*)(VT + (vrow + lr) * 8448 + tpos0 + lc);                                        \
    V1 = *(const uint4*)(VT + (vrow + lr + 32) * 8448 + tpos0 + lc);                                   \
  }
#define swrite(BUF)                                                   \
  {                                                                   \
    *(uint4*)(sK + ((BUF) * 64 + lr) * 72 + lc) = rk0;                \
    *(uint4*)(sK + ((BUF) * 64 + lr + 32) * 72 + lc) = rk1;           \
    *(uint4*)(sV + ((BUF) * 64 + lr) * 72 + lc) = rv0;                \
    *(uint4*)(sV + ((BUF) * 64 + lr + 32) * 72 + lc) = rv1;           \
  }
#define ATT_QK(DST, BUF)                                                                               \
  {                                                                                                    \
    _Pragma("unroll") for (int mt = 0; mt < 4; ++mt) {                                                 \
      const f16x8 a0_ = *(const f16x8*)(sK + ((BUF) * 64 + mt * 16 + c16) * 72 + g * 8);               \
      const f16x8 a1_ = *(const f16x8*)(sK + ((BUF) * 64 + mt * 16 + c16) * 72 + 32 + g * 8);          \
      _Pragma("unroll") for (int nt = 0; nt < 2; ++nt) {                                               \
        DST[mt][nt] = __builtin_amdgcn_mfma_f32_16x16x32_f16(a0_, qf[nt][0], shiftv, 0, 0, 0);     \
        DST[mt][nt] = __builtin_amdgcn_mfma_f32_16x16x32_f16(a1_, qf[nt][1], DST[mt][nt], 0, 0, 0);    \
      }                                                                                                \
    }                                                                                                  \
  }
    f32x4 S[4][2], Sn[4][2];
    const f32x4 shiftv = {-11.5415603f, -11.5415603f, -11.5415603f, -11.5415603f};
    const f16x8 ones8 = {(f16)1.f, (f16)1.f, (f16)1.f, (f16)1.f, (f16)1.f, (f16)1.f, (f16)1.f, (f16)1.f};
    f32x4 lacc[2] = {(f32x4){0.f, 0.f, 0.f, 0.f}, (f32x4){0.f, 0.f, 0.f, 0.f}};
    gload(0, rk0, rk1, rv0, rv1);
    swrite(0);
    gload(1, rk0, rk1, rv0, rv1);
    gload(2, sk0, sk1, sv0, sv1);
    __syncthreads();
    ATT_QK(S, 0)
    swrite(1);
    rk0 = sk0; rk1 = sk1; rv0 = sv0; rv1 = sv1;
    gload(3, sk0, sk1, sv0, sv1);
    __syncthreads();
    int bcur = 0;
#define ATT_SOFTMAX(SC, MODE)                                                                           \
  _Pragma("unroll") for (int nt = 0; nt < 2; ++nt) {                                                    \
    const int dbase = kpos0 + g * 4 - (qb * 128 + wave * 32 + nt * 16 + c16);                           \
    _Pragma("unroll") for (int mt = 0; mt < 4; ++mt)                                                    \
      _Pragma("unroll") for (int i = 0; i < 4; ++i) {                                                   \
        float pv = __builtin_amdgcn_exp2f(SC[mt][nt][i]);                                               \
        if (MODE == 1) pv = (dbase >= -128 - mt * 16 - i) ? pv : 0.f;                                   \
        if (MODE == 2) pv = (dbase <= 128 - mt * 16 - i) ? pv : 0.f;                                    \
        SC[mt][nt][i] = pv;                                                                             \
      }                                                                                                 \
  }
#define ATT_BODY(SC, SN, TT)                                                                            \
  {                                                                                                     \
    const int t = (TT);                                                                                 \
    const int bnext = bcur == 2 ? 0 : bcur + 1;                                                         \
    const int bstage = bnext == 2 ? 0 : bnext + 1;                                                      \
    if (t + 1 < ntile) ATT_QK(SN, bnext)     \
    const int wi = w0 + t;                                                                              \
    const int mmode = (t < nw) ? (wi < 2 ? 1 : (wi >= 4 ? 2 : 0)) : 0;                                  \
    const int kpos0 = (qb - 1) * 128 + wi * 64;                                                         \
    if (mmode == 0) { ATT_SOFTMAX(SC, 0) } else if (mmode == 1) { ATT_SOFTMAX(SC, 1) } else { ATT_SOFTMAX(SC, 2) } \
    _Pragma("unroll") for (int ks = 0; ks < 2; ++ks) {                                                  \
      f16x8 pb[2];                                                                                      \
      _Pragma("unroll") for (int nt = 0; nt < 2; ++nt) {                                                \
        uint4 w = make_uint4(__builtin_bit_cast(unsigned, __builtin_amdgcn_cvt_pkrtz(SC[2 * ks][nt][0], SC[2 * ks][nt][1])),          \
                             __builtin_bit_cast(unsigned, __builtin_amdgcn_cvt_pkrtz(SC[2 * ks][nt][2], SC[2 * ks][nt][3])),          \
                             __builtin_bit_cast(unsigned, __builtin_amdgcn_cvt_pkrtz(SC[2 * ks + 1][nt][0], SC[2 * ks + 1][nt][1])),  \
                             __builtin_bit_cast(unsigned, __builtin_amdgcn_cvt_pkrtz(SC[2 * ks + 1][nt][2], SC[2 * ks + 1][nt][3]))); \
        pb[nt] = __builtin_bit_cast(f16x8, w);                                                          \
        lacc[nt] = __builtin_amdgcn_mfma_f32_16x16x32_f16(ones8, pb[nt], lacc[nt], 0, 0, 0);            \
      }                                                                                                 \
      _Pragma("unroll") for (int dt = 0; dt < 4; ++dt) {                                                \
        const u16* vp = sV + (bcur * 64 + dt * 16 + c16) * 72 + ks * 32 + g * 4;                        \
        uint2 lo = *(const uint2*)vp, hi = *(const uint2*)(vp + 16);                                    \
        f16x8 av = __builtin_bit_cast(f16x8, make_uint4(lo.x, lo.y, hi.x, hi.y));                       \
        _Pragma("unroll") for (int nt = 0; nt < 2; ++nt) oacc[dt][nt] = __builtin_amdgcn_mfma_f32_16x16x32_f16(av, pb[nt], oacc[dt][nt], 0, 0, 0); \
      }                                                                                                 \
    }                                                                                                   \
    if (t + 2 < ntile) swrite(bstage);                           \
    rk0 = sk0; rk1 = sk1; rv0 = sv0; rv1 = sv1;                                                         \
    if (t + 4 < ntile) gload(t + 4, sk0, sk1, sv0, sv1);                                                \
    bcur = bnext;                                                                                       \
    __syncthreads();                                                                                    \
  }
    for (int tt = 0; tt < ntile; tt += 2) {
      ATT_BODY(S, Sn, tt)
      ATT_BODY(Sn, S, tt + 1)
    }
#undef ATT_SOFTMAX
#undef ATT_BODY
    const float sinkv = __expf(p.in(13)[head] - 8.f);
#pragma unroll
    for (int nt = 0; nt < 2; ++nt) {
      const float inv = 1.f / (lacc[nt][0] + sinkv);
      f16* op = O + (size_t)(qtok0 + wave * 32 + nt * 16 + c16) * 1024 + head * 64 + g * 4;
#pragma unroll
      for (int dt = 0; dt < 4; ++dt)
        *(uint2*)(op + dt * 16) = make_uint2(pack_h2(oacc[dt][nt][0] * inv, oacc[dt][nt][1] * inv), pack_h2(oacc[dt][nt][2] * inv, oacc[dt][nt][3] * inv));
    }
  }
#undef gload
#undef swrite
#undef ATT_QK
}

DI float allred8(float x) { DPP_ADD(x, 0xB1); DPP_ADD(x, 0x4E); DPP_ADD(x, 0x141); return x; }
DI void phase_scan(const PA& p, unsigned char* smem) {
  constexpr int BUFF = 6144;
  constexpr int NCH = 528;
  float* sm = (float*)smem;
  const int tid = opaque_tid(), lane = tid & 63, wave = __builtin_amdgcn_readfirstlane(tid >> 6), g = lane >> 4, c16 = lane & 15;
  const f16* R = (const f16*)(p.ws + A_R);
  const f16* KP = (const f16*)(p.ws + A_KP);
  const f16* V = (const f16*)(p.ws + A_V);
  const f16* KKN = (const f16*)(p.ws + A_KKN);
  const f16* BVv = (const f16*)(p.ws + A_BV);
  const f16* TW = (const f16*)(p.ws + A_TW);
  const f16* W2D = (const f16*)(p.ws + OFF_W2DEC);
  for (int item = blockIdx.x; item < 256; item += gridDim.x) {
    const int seq = item >> 1, rh = item & 1, dir = seq >> 6, bh = seq & 63, b = bh >> 4, h = bh & 15;
    const int sgn = dir ? -1 : 1;
    auto cbase = [&](int c) -> int {
      if (dir == 0) return c < 16 ? T_LAT + b * 256 + c * 16 : b * 8192 + (c - 16) * 16;
      return c < 16 ? T_LAT + b * 256 + 255 - c * 16 : b * 8192 + 8191 - (c - 16) * 16;
    };
    if (wave >= 4) {
      const int lt = tid & 255, wq = wave & 3;
      f16* Y = (f16*)(p.ws + (dir ? A_YB : A_YF));
      const f16x8 wb0 = *(const f16x8*)(W2D + (size_t)(dir * 1024 + h * 64 + wq * 16 + c16) * 64 + g * 8);
      const f16x8 wb1 = *(const f16x8*)(W2D + (size_t)(dir * 1024 + h * 64 + wq * 16 + c16) * 64 + 32 + g * 8);
      const float w0v = p.in(17)[dir * 1024 + h * 64 + wq * 16 + c16];
      const int offTW = sgn * c16 * 128 + dir * 64 + g * 8;
      const int offR4 = sgn * (g * 4) * 1024 + h * 64 + wq * 16 + c16;
      const int offE = sgn * (lt >> 4) * 1024 + h * 64 + (lt & 15) * 4;
      const int offV0 = sgn * (lt >> 5) * 1024 + h * 64 + rh * 32 + (lt & 31);
      f16x8 twa0, twa1, twb0, twb1;
      f16 ra0, ra1, ra2, ra3, rb0, rb1, rb2, rb3, va0, va1, vb0, vb1;
      uint2 kka, bva, kpa, rra, kkb, bvb, kpb, rrb;
#define LD_GLOAD(C, TW0, TW1, R0, R1, R2, R3, KK, BV, KPv, RR, V0, V1)                 \
  {                                                                                    \
    const int cb_ = cbase(C);                                                          \
    const f16* tp_ = TW + (size_t)cb_ * 128 + offTW;                                   \
    TW0 = *(const f16x8*)tp_; TW1 = *(const f16x8*)(tp_ + 32);                         \
    const f16* rp_ = R + (size_t)cb_ * 1024 + offR4;                                   \
    R0 = rp_[0]; R1 = rp_[sgn * 1024]; R2 = rp_[sgn * 2048]; R3 = rp_[sgn * 3072];     \
    const size_t o_ = (size_t)cb_ * 1024 + offE;                                       \
    KK = *(const uint2*)(KKN + o_); BV = *(const uint2*)(BVv + o_);                    \
    KPv = *(const uint2*)(KP + o_);                                                    \
    V0 = V[(size_t)cb_ * 1024 + offV0]; V1 = V[(size_t)cb_ * 1024 + offV0 + sgn * 8192]; \
  }
#define LD_PROCESS(BUF, TW0, TW1, R0, R1, R2, R3, KK, BV, KPv, RR, V0, V1)             \
  {                                                                                    \
    float* B_ = sm + (BUF) * BUFF;                                                     \
    f32x4 ca = (f32x4){0.f, 0.f, 0.f, 0.f};                                            \
    ca = __builtin_amdgcn_mfma_f32_16x16x32_f16(TW0, wb0, ca, 0, 0, 0);                \
    ca = __builtin_amdgcn_mfma_f32_16x16x32_f16(TW1, wb1, ca, 0, 0, 0);                \
    const int ch_ = wq * 16 + c16;                                                     \
    const float rf_[4] = {(float)R0, (float)R1, (float)R2, (float)R3};                 \
    _Pragma("unroll") for (int i = 0; i < 4; ++i) {                                    \
      const float z_ = w0v + ca[i];                                                    \
      const float w_ = __expf(-0.60653066f * __builtin_amdgcn_rcpf(1.f + __expf(-z_)));     \
      B_[2048 + (g * 4 + i) * 64 + ch_] = w_;                                          \
      B_[1024 + (g * 4 + i) * 64 + ch_] = rf_[i];     \
    }                                                                                  \
    const f16x4 kk = __builtin_bit_cast(f16x4, KK), bv = __builtin_bit_cast(f16x4, BV), kp = __builtin_bit_cast(f16x4, KPv); \
    const int st_ = lt >> 4, c4_ = (lt & 15) * 4;                                      \
    *(float4*)(B_ + st_ * 64 + c4_) = make_float4(-(float)kk[0], -(float)kk[1], -(float)kk[2], -(float)kk[3]);          \
    *(float4*)(B_ + 3072 + st_ * 64 + c4_) = make_float4((float)bv[0], (float)bv[1], (float)bv[2], (float)bv[3]);      \
    *(float4*)(B_ + 4096 + st_ * 64 + c4_) = make_float4((float)kp[0], (float)kp[1], (float)kp[2], (float)kp[3]);      \
    B_[5120 + ((lt >> 5) * 16 + ((lt & 31) >> 1)) * 4 + (lt & 1)] = (float)V0;         \
    B_[5120 + (((lt >> 5) + 8) * 16 + ((lt & 31) >> 1)) * 4 + (lt & 1)] = (float)V1;   \
  }
#define Y_FLUSH(CC, YB) {     \
          const float* yp_ = sm + 2 * BUFF + (YB) * 8192 + ((lt >> 4) * 16 + (lt & 15)) * 32;                                          \
          float ya_ = 0.f, yb_ = 0.f;                                                                                                  \
          _Pragma("unroll") for (int q_ = 0; q_ < 8; ++q_) {                                                                           \
            const float4 t_ = *(const float4*)(yp_ + (((q_ + lt) & 7) << 2));     \
            ya_ += t_.x + t_.z; yb_ += t_.y + t_.w;                                                                                    \
          }                                                                                                                            \
          *(unsigned*)(Y + (size_t)(cbase(CC) + sgn * (lt >> 4)) * 1024 + h * 64 + rh * 32 + 2 * (lt & 15)) = pack_h2(ya_, yb_);       \
        }
#define LD_GLOAD_S(C, X) LD_GLOAD(C, tw##X##0, tw##X##1, r##X##0, r##X##1, r##X##2, r##X##3, kk##X, bv##X, kp##X, rr##X, v##X##0, v##X##1)
#define LD_PROCESS_S(BUF, X) LD_PROCESS(BUF, tw##X##0, tw##X##1, r##X##0, r##X##1, r##X##2, r##X##3, kk##X, bv##X, kp##X, rr##X, v##X##0, v##X##1)
#define ROT(X, Y) tw##X##0 = tw##Y##0; tw##X##1 = tw##Y##1; r##X##0 = r##Y##0; r##X##1 = r##Y##1; r##X##2 = r##Y##2; r##X##3 = r##Y##3; \
                  kk##X = kk##Y; bv##X = bv##Y; kp##X = kp##Y; rr##X = rr##Y; v##X##0 = v##Y##0; v##X##1 = v##Y##1;
      f16x8 twc0, twc1, twd0, twd1;
      f16 rc0, rc1, rc2, rc3, rd0, rd1, rd2, rd3, vc0, vc1, vd0, vd1;
      uint2 kkc, bvc, kpc, rrc, kkd, bvd, kpd, rrd;
      LD_GLOAD_S(0, a)
      LD_PROCESS_S(0, a)
      LD_GLOAD_S(1, a)
      __syncthreads();
      for (int c = 0; c < NCH; ++c) {
        const int cur = c & 1;
        if (c + 2 < NCH) LD_GLOAD_S(c + 2, b)
        if (c + 1 < NCH) LD_PROCESS_S(cur ^ 1, a)
        if (c > 16) Y_FLUSH(c - 1, cur ^ 1)
        ROT(a, b)
        __syncthreads();
      }
      Y_FLUSH(NCH - 1, 1)
#undef LD_GLOAD
#undef LD_PROCESS
#undef LD_GLOAD_S
#undef LD_PROCESS_S
#undef ROT
#undef Y_FLUSH
    } else {
      const int rp = tid >> 4, j = tid & 15;
      f32x2 sA01 = {0.f, 0.f}, sA23 = {0.f, 0.f}, sB01 = {0.f, 0.f}, sB23 = {0.f, 0.f};
      __syncthreads();
      for (int c = 0; c < NCH; ++c) {
        const int cur = c & 1;
        const float* B = sm + cur * BUFF;
        float* ypw = sm + 2 * BUFF + cur * 8192 + (rp * 16 + j) * 2;
#define SC_LOAD(S, I)                                                             \
  const f32x4 a##S = *(const f32x4*)(B + (I) * 64 + j * 4);                       \
  const f32x4 r##S = *(const f32x4*)(B + 1024 + (I) * 64 + j * 4);                \
  const f32x4 w##S = *(const f32x4*)(B + 2048 + (I) * 64 + j * 4);                \
  const f32x4 b##S = *(const f32x4*)(B + 3072 + (I) * 64 + j * 4);                \
  const f32x4 k##S = *(const f32x4*)(B + 4096 + (I) * 64 + j * 4);                \
  const f32x2 q##S = *(const f32x2*)(B + 5120 + ((I) * 16 + rp) * 4);
#define SC_STEP(S, I)                                                             \
  {                                                                               \
    f32x2 tA_ = sA01 * a##S.xy; tA_ = sA23 * a##S.zw + tA_;                       \
    f32x2 tB_ = sB01 * a##S.xy; tB_ = sB23 * a##S.zw + tB_;                       \
    float d1A_ = tA_.x + tA_.y, d1B_ = tB_.x + tB_.y;                             \
    d1A_ = allred16(d1A_); d1B_ = allred16(d1B_);                                 \
    const f32x2 dA_ = {d1A_, d1A_}, vA_ = {q##S.x, q##S.x}, dB_ = {d1B_, d1B_}, vB_ = {q##S.y, q##S.y}; \
    f32x2 x_;                                                                     \
    x_ = k##S.xy * vA_; x_ = b##S.xy * dA_ + x_; sA01 = sA01 * w##S.xy + x_;      \
    x_ = k##S.zw * vA_; x_ = b##S.zw * dA_ + x_; sA23 = sA23 * w##S.zw + x_;      \
    x_ = k##S.xy * vB_; x_ = b##S.xy * dB_ + x_; sB01 = sB01 * w##S.xy + x_;      \
    x_ = k##S.zw * vB_; x_ = b##S.zw * dB_ + x_; sB23 = sB23 * w##S.zw + x_;      \
      \
    f32x2 uA_ = sA01 * r##S.xy; uA_ = sA23 * r##S.zw + uA_;                       \
    f32x2 uB_ = sB01 * r##S.xy; uB_ = sB23 * r##S.zw + uB_;                       \
    *(float2*)(ypw + (I) * 512) = make_float2(uA_.x + uA_.y, uB_.x + uB_.y);      \
  }
        {
          SC_LOAD(0, 0) SC_LOAD(1, 1)
          SC_STEP(0, 0) SC_LOAD(2, 2)
          SC_STEP(1, 1) SC_LOAD(3, 3)
          SC_STEP(2, 2) SC_LOAD(4, 4)
          SC_STEP(3, 3) SC_LOAD(5, 5)
          SC_STEP(4, 4) SC_LOAD(6, 6)
          SC_STEP(5, 5) SC_LOAD(7, 7)
          SC_STEP(6, 6) SC_LOAD(8, 8)
          SC_STEP(7, 7) SC_LOAD(9, 9)
          SC_STEP(8, 8) SC_LOAD(10, 10)
          SC_STEP(9, 9) SC_LOAD(11, 11)
          SC_STEP(10, 10) SC_LOAD(12, 12)
          SC_STEP(11, 11) SC_LOAD(13, 13)
          SC_STEP(12, 12) SC_LOAD(14, 14)
          SC_STEP(13, 13) SC_LOAD(15, 15)
          SC_STEP(14, 14)
          SC_STEP(15, 15)
        }
#undef SC_LOAD
#undef SC_STEP
        __syncthreads();
      }
    }
    __syncthreads();
  }
}

DI void phase_readout(const PA& p, unsigned char* smem) {
  const int tid = vtid(), row = tid >> 1, half = tid & 1;
  const float* cr = (const float*)smem + row * 132 + half * 64;
  const f16* Gs = (const f16*)(p.ws + A_G);
  const f16* G2 = (const f16*)(p.ws + OFF_G2);
  const f16* V = (const f16*)(p.ws + A_V);
  const float* RK = (const float*)(p.ws + OFF_RK);
  f16* O1 = (f16*)(p.ws + A_O1);
  for (int t = vbid(); t < 256 * 8; t += vgrid()) {
    const int m = t >> 3, n = t & 7;
    const int tok = m * 128 + row, head = n * 2 + half, ch0 = head * 64;
    f16x2 part[32];
#pragma unroll
    for (int c = 0; c < 32; ++c) part[c] = (f16x2){(f16)0.f, (f16)0.f};
    const float rk = RK[(size_t)tok * 16 + head];
    const float* gng = p.in(28) + ch0; const float* gnb = p.in(29) + ch0;
#pragma unroll 1
    for (int d = 0; d < 2; ++d) {
      f32x4 acc[4][4];
      gemm_mainloop<false>(acc, Gs + (size_t)m * 128 * 256 + d * 128, 256, nullptr, nullptr, G2 + (size_t)d * 1024 * 128 + (size_t)n * 128 * 128, 128, 128, smem);
      stage_c(acc, smem);
      const f16* yp = (const f16*)(p.ws + (d ? A_YB : A_YF)) + (size_t)tok * 1024 + ch0;
      const f16* vp = V + (size_t)tok * 1024 + ch0;
      f16x8 yv[8];
      float mean = 0.f;
#pragma unroll
      for (int q = 0; q < 8; ++q) {
        yv[q] = *(const f16x8*)(yp + q * 8);
#pragma unroll
        for (int e = 0; e < 8; ++e) mean += (float)yv[q][e];
      }
      mean *= (1.f / 64.f);
      float var = 0.f;
#pragma unroll
      for (int q = 0; q < 8; ++q)
#pragma unroll
        for (int e = 0; e < 8; ++e) { float dlt = (float)yv[q][e] - mean; var += dlt * dlt; }
      const float rs = rsqrtf(var * (1.f / 64.f) + 64e-5f);
#pragma unroll
      for (int q = 0; q < 8; ++q) {
        f16x8 vv = *(const f16x8*)(vp + q * 8);
#pragma unroll
        for (int e = 0; e < 8; ++e) {
          const int c = q * 8 + e;
          const float gn = ((float)yv[q][e] - mean) * rs * gng[c] + gnb[c];
          part[c >> 1][c & 1] = (f16)((float)part[c >> 1][c & 1] + (gn + rk * (float)vv[e]) * cr[c]);
        }
      }
      __syncthreads();
    }
    f16* dst = O1 + (size_t)tok * 1024 + ch0;
#pragma unroll
    for (int q = 0; q < 8; ++q)
      *(uint4*)(dst + q * 8) = make_uint4(__builtin_bit_cast(unsigned, part[q * 4]), __builtin_bit_cast(unsigned, part[q * 4 + 1]),
                                          __builtin_bit_cast(unsigned, part[q * 4 + 2]), __builtin_bit_cast(unsigned, part[q * 4 + 3]));
  }
}

__global__ void __launch_bounds__(512) mega(Params p0) {
  extern __shared__ __attribute__((aligned(16))) unsigned char smem[];
  cg::grid_group grid = cg::this_grid();
  volatile LAS unsigned* xb_st = (volatile LAS unsigned*)(smem + 2 * LDS_HALF);
  if (threadIdx.x == 0) { xb_st[0] = 0u; xb_st[1] = 0u; xb_st[2] = 0u; xb_st[3] = blockIdx.x; }
  __syncthreads();
  const XcdBarrier xb = xcd_barrier_post((unsigned*)(p0.ws + OFF_BAR), xb_st);
  for (int ph = p0.ph_lo; ph < p0.ph_hi; ++ph) {
   for (int rep = 0; rep <= (int)((REPEAT_MASK >> ph) & 1u); ++rep) {
    KParams kp = (KParams)__builtin_amdgcn_kernarg_segment_ptr();
    asm volatile("" : "+s"(kp));
    PA p;
    p.k = kp;
    p.ws = kp->ws;
    p.out = kp->out;
    unsigned char* ws = p.ws;
    unsigned char* vsm = smem + vhalf() * LDS_HALF;
    const float* mod = (const float*)(ws + OFF_MOD);
    float* xc = (float*)(ws + OFF_XC);
    BigArgs ba;
    int big = -1;
    switch (ph) {
      case 0: phase0(p, vsm); break;
      case 1: phase_norm(p.in(0), p.in(2), p.in(6), mod, 0, (f16*)(ws + A_H), T_ALL); break;
      case 2: ba = BigArgs{(const f16*)(ws + A_H), (const f16*)(ws + A_H), (const f16*)(ws + A_WQKV), 1024, 1024, 16, 16, 128, 6, GemmArgs{}}; big = EPI_QKV; break;
      case 3: phase_attn(p, vsm); break;
      case 4: ba = BigArgs{(const f16*)(ws + A_O), (const f16*)(ws + A_O), (const f16*)(ws + A_WO0), 1024, 1024, 16, 16, 128, 4,
                           GemmArgs{nullptr, nullptr, 0, 0, 0, 0, 0, 0, p.in(0), p.in(2), p.out, xc, mod + 2 * 1024, nullptr}}; big = EPI_RES; break;
      case 5: phase_norm(p.out, xc, p.in(7), mod, 3, (f16*)(ws + A_H), T_ALL); break;
      case 6: ba = BigArgs{(const f16*)(ws + A_H), (const f16*)(ws + A_H), (const f16*)(ws + A_W1_0), 1024, 1024, 16, 16, 128, 16,
                           GemmArgs{nullptr, nullptr, 0, 0, 0, 0, 0, 0, nullptr, nullptr, nullptr, nullptr, nullptr, (f16*)(ws + A_U)}}; big = EPI_MLP1; break;
      case 7: ba = BigArgs{(const f16*)(ws + A_U), (const f16*)(ws + A_U), (const f16*)(ws + A_W2_0), 4096, 4096, 64, 64, 128, 4,
                           GemmArgs{nullptr, nullptr, 0, 0, 0, 0, 0, 0, p.out, xc, p.out, xc, mod + 5 * 1024, nullptr}}; big = EPI_RES; break;
      case 8: {
        phase_shift(p, vsm);
        int base = T_ALL / 8;
        f16* WF = (f16*)(ws + A_WFEAT);
        const float* mu = p.in(15);
        for (int mm = 0; mm < 3; ++mm) {
          const float* src = p.in(16) + (size_t)mm * 1024 * 1024;
          f16* dst = WF + (size_t)mm * 1024 * 2048;
          conv_job(src, 1024, 1024, dst, 2048, base, vsm);
          conv_job(src, 1024, 1024, dst + 1024, 2048, base, vsm, mu + (mm == 0 ? 0 : (mm == 1 ? 2 : 3)) * 1024);
        }
        for (int d = 0; d < 2; ++d) {
          const float* src = p.in(18) + (size_t)d * 1024 * 64;
          f16* dst = WF + (size_t)(3072 + d * 64) * 2048;
          conv_job(src, 1024, 64, dst, 2048, base, vsm);
          conv_job(src, 1024, 64, dst + 1024, 2048, base, vsm, mu + 1 * 1024);
        }
        conv_job(p.in(21), 1024, 64, WF + (size_t)3200 * 2048, 2048, base, vsm);
        conv_job(p.in(21), 1024, 64, WF + (size_t)3200 * 2048 + 1024, 2048, base, vsm, mu + 4 * 1024);
        for (int d = 0; d < 2; ++d) {
          const float* src = p.in(23) + (size_t)d * 1024 * 128;
          f16* dst = WF + (size_t)(3328 + d * 128) * 2048;
          conv_job(src, 1024, 128, dst, 2048, base, vsm);
          conv_job(src, 1024, 128, dst + 1024, 2048, base, vsm, mu + 5 * 1024);
        }
      } break;
      case 9: ba = BigArgs{(const f16*)(ws + A_H), (const f16*)(ws + A_XX), (const f16*)(ws + A_WFEAT), 1024, 2048, 16, 32, 128, 14, GemmArgs{}}; big = EPI_FEAT; break;
      case 10: {
        GemmArgs ga{(const f16*)(ws + A_AI), (const f16*)(ws + OFF_A2), 64, 64, 64, 264, 8, EPI_B2, nullptr, nullptr, nullptr, nullptr, nullptr, nullptr};
        gemm_phase<EPI_B2>(p, ga, vsm);
      } break;
      case 11: phase_scan(p, smem); break;
      case 12: {
        phase_readout(p, vsm);
        int base = 2048;
        conv_job(p.in(8) + (size_t)1024 * 4096, 1024, 4096, (f16*)(ws + A_W1_1), 1024, base, vsm);
        conv_job(p.in(9) + (size_t)4096 * 1024, 4096, 1024, (f16*)(ws + A_W2_1), 4096, base, vsm);
      } break;
      case 13: ba = BigArgs{(const f16*)(ws + A_O1), (const f16*)(ws + A_O1), (const f16*)(ws + OFF_WO1), 1024, 1024, 16, 16, 128, 4,
                            GemmArgs{nullptr, nullptr, 0, 0, 0, 0, 0, 0, p.out, xc, p.out, xc, mod + 5 * 6144 + 2 * 1024, nullptr}}; big = EPI_RES; break;
      case 14: phase_norm(p.out, xc, p.in(7) + 1024, mod + 5 * 6144, 3, (f16*)(ws + A_H2), T_LAT); break;
      case 15: ba = BigArgs{(const f16*)(ws + A_H2), (const f16*)(ws + A_H2), (const f16*)(ws + A_W1_1), 1024, 1024, 16, 16, 128, 16,
                            GemmArgs{nullptr, nullptr, 0, 0, 0, 0, 0, 0, nullptr, nullptr, nullptr, nullptr, nullptr, (f16*)(ws + A_U1)}}; big = EPI_MLP1; break;
      case 16: ba = BigArgs{(const f16*)(ws + A_U1), (const f16*)(ws + A_U1), (const f16*)(ws + A_W2_1), 4096, 4096, 64, 64, 128, 4,
                            GemmArgs{nullptr, nullptr, 0, 0, 0, 0, 0, 0, p.out, xc, p.out, xc, mod + 5 * 6144 + 5 * 1024, nullptr}}; big = EPI_RES; break;
      default: break;
    }
    if (big == EPI_QKV) gemm256_phase<EPI_QKV>(p, ba, smem);
    else if (big == EPI_RES) gemm256s_phase<EPI_RES>(p, ba, smem);
    else if (big == EPI_MLP1) gemm256s_phase<EPI_MLP1>(p, ba, smem);
    else if (big == EPI_FEAT) gemm256s_phase<EPI_FEAT>(p, ba, smem);
    if (big >= 0 && ba.nM == 128 && ph < 10) {
      GemmArgs ga = ba.e;
      ga.A = ba.A1; ga.Bt = ba.Bt; ga.lda = ba.lda; ga.ldb = ba.ldb; ga.K = ba.nk1 * 64; ga.MT = 8; ga.NT = ba.nN * 2;
      if (big == EPI_QKV) gemm_phase<EPI_QKV>(p, ga, vsm, 256);
      else if (big == EPI_RES) gemm_phase<EPI_RES>(p, ga, vsm, 256);
      else if (big == EPI_MLP1) gemm_phase<EPI_MLP1>(p, ga, vsm, 256);
      else gemm_phase<EPI_FEAT>(p, ga, vsm, 256, ba.A2, (const f16*)(ws + OFF_MU16));
    }
    if (ph + 1 < p0.ph_hi || rep < (int)((REPEAT_MASK >> ph) & 1u)) {
      if (p0.ph_lo < 0) grid.sync();
      if (ph == 0 && rep == 0) {
        xcd_barrier(xb);
        if (threadIdx.x == 0) {
          unsigned* bar = (unsigned*)(p0.ws + OFF_BAR);
          const unsigned per = gridDim.x >> 3;
          bool uniform = (gridDim.x & 7u) == 0u;
#pragma unroll 1
          for (unsigned jx = 0; jx < 16; ++jx) { const unsigned cnt = xb_ld(&bar[XB_XCNT(jx)]); uniform = uniform && (cnt == (jx < 8 ? per : 0u)); }
          xb_st[3] = uniform ? (xb_st[2] * 8u + xb.x) : blockIdx.x;
        }
        __syncthreads();
      } else xcd_barrier(xb);
    }
   }
  }
}

extern "C" void kernel_launch(void* const* d_in, const int* in_sizes, int n_in, void* d_out, int out_size, void* d_ws, size_t ws_size,
                              hipStream_t stream) {
  static int grid_blocks = 0;
  if (!grid_blocks) {
    if (n_in != 31 || ws_size < WS_NEED) { fprintf(stderr, "kernel_launch: unexpected n_in %d or ws_size %zu (< %zu)\n", n_in, ws_size, (size_t)WS_NEED); grid_blocks = -1; return; }
    int dev = 0, cus = 0, per_cu = 0;
    (void)hipGetDevice(&dev);
    (void)hipDeviceGetAttribute(&cus, hipDeviceAttributeMultiprocessorCount, dev);
    (void)hipFuncSetAttribute((const void*)mega, hipFuncAttributeMaxDynamicSharedMemorySize, LDS_BYTES);
    (void)hipOccupancyMaxActiveBlocksPerMultiprocessor(&per_cu, mega, 512, LDS_BYTES);
    if (per_cu < 1) { fprintf(stderr, "kernel_launch: occupancy query says %d blocks/CU\n", per_cu); }
    grid_blocks = cus;
    if (grid_blocks < 16) { fprintf(stderr, "kernel_launch: too few CUs (%d)\n", cus); grid_blocks = -1; return; }
  }
  if (grid_blocks < 0) return;
  Params p{};
  for (int i = 0; i < 31; ++i) p.in[i] = (const float*)d_in[i];
  p.out = (float*)d_out;
  p.ws = (unsigned char*)d_ws;
  p.ph_lo = 0;
  p.ph_hi = NPHASE;
  (void)hipMemsetAsync((unsigned char*)d_ws + OFF_BAR, 0, XCD_BAR_WORDS * sizeof(unsigned), stream);
  void* args[] = {&p};
  hipError_t e = hipLaunchCooperativeKernel((const void*)mega, dim3(grid_blocks), dim3(512), args, LDS_BYTES, stream);
  if (e != hipSuccess) fprintf(stderr, "cooperative launch failed: %s (grid %d)\n", hipGetErrorString(e), grid_blocks);
}
```

```cpp
#include <hip/hip_runtime.h>
#include <hip/hip_cooperative_groups.h>
#include <cstdio>
namespace cg = cooperative_groups;

#define DI __device__ __forceinline__
typedef _Float16 f16;
typedef _Float16 f16x8 __attribute__((ext_vector_type(8)));
typedef _Float16 f16x4 __attribute__((ext_vector_type(4)));
typedef _Float16 f16x2 __attribute__((ext_vector_type(2)));
typedef short bf16x8 __attribute__((ext_vector_type(8)));
typedef short s16x4 __attribute__((ext_vector_type(4)));
typedef float f32x4 __attribute__((ext_vector_type(4)));
typedef float f32x2 __attribute__((ext_vector_type(2)));
typedef unsigned short u16;

constexpr int T_ALL = 33792, T_LAT = 32768;
constexpr unsigned MiB = 1048576;
constexpr int LDS_HALF = 73728;
constexpr int LDS_BYTES = 2 * LDS_HALF + 64;
constexpr int NPHASE = 17;
#ifndef REPEAT_MASK
#define REPEAT_MASK 0u
#endif

#define XB_TMO      128
#define XB_XCNT(j)  (256  + 64 * (j))
#define XB_XSUB(j)  (1280 + 64 * (j))
#define XB_XGEN(j)  (2304 + 64 * (j))
#define XB_TOP      3328
#define XB_TOPGEN   3392
#define XCD_BAR_WORDS 3456
#define XB_SPIN_CAP (1u << 18)
#define LAS __attribute__((address_space(3)))

__device__ __forceinline__ unsigned xb_ld(unsigned* p)              { return __hip_atomic_load(p, __ATOMIC_RELAXED, __HIP_MEMORY_SCOPE_AGENT); }
__device__ __forceinline__ unsigned xb_add(unsigned* p, unsigned v) { return __hip_atomic_fetch_add(p, v, __ATOMIC_RELAXED, __HIP_MEMORY_SCOPE_AGENT); }
__device__ __forceinline__ unsigned xb_xcc_id() { return (unsigned)__builtin_amdgcn_s_getreg((3 << 11) | 20) & 0xFu; }
#define XB_SPIN(cond, bar) do { unsigned _sp = 0; while (cond) { __builtin_amdgcn_s_sleep(1); \
    if ((++_sp & 255u) == 0u) { if (xb_ld(&(bar)[XB_TMO])) break; if (_sp > XB_SPIN_CAP) { atomicAdd(&(bar)[XB_TMO], 1u); break; } } } } while (0)

struct XcdBarrier {
    unsigned* bar; unsigned x;
    volatile LAS unsigned* st;
};

__device__ __forceinline__ XcdBarrier xcd_barrier_post(unsigned* bar, volatile LAS unsigned* st) {
    XcdBarrier b; b.bar = bar; b.x = xb_xcc_id(); b.st = st;
    if (threadIdx.x == 0) st[2] = xb_add(&bar[XB_XCNT(b.x)], 1u);
    return b;
}
__device__ __forceinline__ void xcd_barrier_complete(unsigned* bar, unsigned x, unsigned& nloc, unsigned& nx) {
    const unsigned G = gridDim.x * gridDim.y * gridDim.z;
    unsigned sum, cnt, mine, sp = 0u;
    for (;;) {
        sum = 0u; cnt = 0u; mine = 0u;
#pragma unroll 1
        for (unsigned j = 0; j < 16; ++j) { const unsigned c = xb_ld(&bar[XB_XCNT(j)]); sum += c; cnt += (c > 0u) ? 1u : 0u; mine = (j == x) ? c : mine; }
        if (sum == G) break;
        __builtin_amdgcn_s_sleep(1);
        if ((++sp & 255u) == 0u) { if (xb_ld(&bar[XB_TMO])) break; if (sp > XB_SPIN_CAP) { atomicAdd(&bar[XB_TMO], 1u); break; } }
    }
    nloc = mine > 0u ? mine : 1u; nx = cnt > 0u ? cnt : 1u;
}

__device__ __forceinline__ void xcd_barrier(const XcdBarrier& b) {
    asm volatile("s_waitcnt vmcnt(0)" ::: "memory");
    __syncthreads();
    if (threadIdx.x == 0) {
        unsigned* bar = b.bar;
        asm volatile("" : "+s"(bar));
        __builtin_amdgcn_s_waitcnt(0);
        unsigned nloc = b.st[0], nx = b.st[1];
        if (nloc == 0u) { xcd_barrier_complete(bar, b.x, nloc, nx); b.st[0] = nloc; b.st[1] = nx; }
        const unsigned old = xb_add(&bar[XB_XSUB(b.x)], 1u);
        const unsigned gen = old / nloc;
        if (old + 1u == (gen + 1u) * nloc) {
            __builtin_amdgcn_fence(__ATOMIC_RELEASE, "agent");
            asm volatile("s_waitcnt vmcnt(0)" ::: "memory");
            const unsigned og = xb_add(&bar[XB_TOP], 1u);
            const unsigned tg = og / nx;
            if (og + 1u == (tg + 1u) * nx) xb_add(&bar[XB_TOPGEN], 1u);
            else XB_SPIN(xb_ld(&bar[XB_TOPGEN]) == tg, bar);
            __builtin_amdgcn_fence(__ATOMIC_ACQUIRE, "agent");
            xb_add(&bar[XB_XGEN(b.x)], 1u);
            asm volatile("s_waitcnt vmcnt(0)" ::: "memory");
        } else {
            XB_SPIN(xb_ld(&bar[XB_XGEN(b.x)]) == gen, bar);
            __builtin_amdgcn_fence(__ATOMIC_ACQUIRE, "agent");
            asm volatile("s_waitcnt vmcnt(0)" ::: "memory");
        }
    }
    __syncthreads();
}


constexpr unsigned OFF_MOD = 0;
constexpr unsigned OFF_ROPE = 256 * 1024;
constexpr unsigned OFF_MU16 = 288 * 1024;
constexpr unsigned OFF_BAR = 512 * 1024;
constexpr unsigned OFF_RK = 1 * MiB;
constexpr unsigned OFF_XC = 4 * MiB;
constexpr unsigned OFF_W2DEC = 8 * MiB;
constexpr unsigned OFF_A2 = 8 * MiB + 256 * 1024;
constexpr unsigned OFF_G2 = 8 * MiB + 384 * 1024;
constexpr unsigned OFF_WO1 = 9 * MiB;
constexpr unsigned ARENA = 12 * MiB;
constexpr unsigned A_H = ARENA, A_Q = ARENA + 66 * MiB, A_K = ARENA + 132 * MiB, A_VT = ARENA + 149 * MiB, A_O = ARENA + 166 * MiB,
                 A_U = ARENA + 66 * MiB;
constexpr unsigned A_WQKV = ARENA + 400 * MiB, A_WO0 = ARENA + 403 * MiB, A_W1_0 = ARENA + 405 * MiB, A_W2_0 = ARENA + 413 * MiB;
constexpr unsigned A_XX = ARENA + 66 * MiB, A_R = ARENA + 132 * MiB, A_KP = ARENA + 198 * MiB, A_V = ARENA + 264 * MiB,
                 A_TW = ARENA + 330 * MiB, A_G = ARENA + 339 * MiB, A_AI = ARENA + 356 * MiB, A_WFEAT = ARENA + 400 * MiB;
constexpr unsigned A_KKN = ARENA, A_BV = ARENA + 66 * MiB, A_YF = ARENA + 361 * MiB, A_YB = ARENA + 425 * MiB;
constexpr unsigned A_W1_1 = ARENA, A_W2_1 = ARENA + 8 * MiB, A_O1 = ARENA + 66 * MiB, A_H2 = ARENA + 132 * MiB, A_U1 = ARENA + 198 * MiB;
constexpr unsigned WS_NEED = ARENA + 489 * MiB;

struct Params {
  const float* in[31];
  float* out;
  unsigned char* ws;
  int ph_lo, ph_hi;
};
typedef const Params __attribute__((address_space(4)))* KParams;
struct PA {
  KParams k;
  float* out;
  unsigned char* ws;
  __device__ __forceinline__ const float* in(int i) const { return k->in[i]; }
};

enum { EPI_QKV = 0, EPI_RES = 1, EPI_MLP1 = 2, EPI_B2 = 3, EPI_FEAT = 4 };
struct GemmArgs {
  const f16* A; const f16* Bt; int lda, ldb, K, MT, NT, epi;
  const float* srcLat; const float* srcCtx; float* dstLat; float* dstCtx; const float* gt;
  f16* dstH;
};

DI int opaque_tid() { int t = threadIdx.x; asm volatile("" : "+v"(t)); return t; }
DI int vtid() { return opaque_tid() & 255; }
DI int vhalf() { return __builtin_amdgcn_readfirstlane((int)(threadIdx.x >> 8)); }
DI int vbid() { return (int)blockIdx.x * 2 + vhalf(); }
DI int vgrid() { return (int)gridDim.x * 2; }
template <class T> DI T* opaque_ptr(T* q) { asm volatile("" : "+s"(q)); return q; }
#define DPP_ADD(v, CTRL) (v) += __builtin_bit_cast(float, __builtin_amdgcn_update_dpp(0, __builtin_bit_cast(int, (v)), (CTRL), 0xf, 0xf, true))
DI float allred16(float x) { DPP_ADD(x, 0xB1); DPP_ADD(x, 0x4E); DPP_ADD(x, 0x141); DPP_ADD(x, 0x128); return x; }
DI float bperm_xor(float v, int lane, int o) { return __builtin_bit_cast(float, __builtin_amdgcn_ds_bpermute((lane ^ o) << 2, __builtin_bit_cast(int, v))); }
DI float wave_sum(float x, int lane) {
  x = allred16(x);
  x += bperm_xor(x, lane, 16);
  x += bperm_xor(x, lane, 32);
  return x;
}
DI unsigned pack_h2(float a, float b) { f16x2 v = {(f16)a, (f16)b}; return __builtin_bit_cast(unsigned, v); }
DI unsigned short bf16_rne(float x) { unsigned u = __float_as_uint(x); u += 0x7fffu + ((u >> 16) & 1u); return (unsigned short)(u >> 16); }
DI unsigned pack_bf2(float a, float b) { return (unsigned)bf16_rne(a) | ((unsigned)bf16_rne(b) << 16); }
DI float sigmoidf_(float x) { return __builtin_amdgcn_rcpf(1.f + __expf(-x)); }
DI float tanhf_(float x) { return 1.f - 2.f * __builtin_amdgcn_rcpf(__expf(2.f * x) + 1.f); }

DI void conv_tile(const float* __restrict__ src, int N, f16* __restrict__ dst, int ldd, int tile, unsigned char* smem, const float* __restrict__ scale = nullptr) {
  float* t = (float*)smem;
  const int tid = vtid();
  const int ntn = N >> 6;
  const int kt = tile / ntn, nt = tile - kt * ntn;
#pragma unroll
  for (int p = 0; p < 4; ++p) {
    int r = (tid >> 4) + 16 * p, c4 = (tid & 15) * 4;
    float4 v = *(const float4*)(src + (size_t)(kt * 64 + r) * N + nt * 64 + c4);
    if (scale) { const float sv = scale[kt * 64 + r]; v.x *= sv; v.y *= sv; v.z *= sv; v.w *= sv; }
    t[r * 65 + c4] = v.x; t[r * 65 + c4 + 1] = v.y; t[r * 65 + c4 + 2] = v.z; t[r * 65 + c4 + 3] = v.w;
  }
  __syncthreads();
  const int n = tid >> 2, ks = (tid & 3) * 16;
  unsigned w[8];
#pragma unroll
  for (int q = 0; q < 8; ++q) w[q] = pack_h2(t[(ks + 2 * q) * 65 + n], t[(ks + 2 * q + 1) * 65 + n]);
  f16* d = dst + (size_t)(nt * 64 + n) * ldd + kt * 64 + ks;
  *(uint4*)d = make_uint4(w[0], w[1], w[2], w[3]);
  *(uint4*)(d + 8) = make_uint4(w[4], w[5], w[6], w[7]);
  __syncthreads();
}
DI void conv_job(const float* src, int K, int N, f16* dst, int ldd, int& base, unsigned char* smem, const float* scale = nullptr) {
  const int ntile = (K >> 6) * (N >> 6);
  const int G = vgrid(), bid = vbid();
  int first = base + ((bid - (base % G) + G) % G);
  for (int gi = first; gi < base + ntile; gi += G) conv_tile(src, N, dst, ldd, gi - base, smem, scale);
  base += ntile;
}

DI void mod_item(const PA& p, int it, unsigned char* smem) {
  const int tid = vtid();
  const int layer = it / 96, n0 = (it % 96) * 64;
  float* sc = (float*)smem;
  float* red = sc + 5120;
  for (int e = tid; e < 5120; e += 256) {
    int r = e >> 10, k = e & 1023;
    float v = (r < 4) ? p.in(1)[r * 1024 + k] : p.in(3)[k];
    sc[e] = v / (1.f + expf(-v));
  }
  __syncthreads();
  const int col = tid & 63, kg = tid >> 6;
  const float* w = p.in(4) + (size_t)layer * 1024 * 6144 + n0 + col;
  float a0 = 0, a1 = 0, a2 = 0, a3 = 0, a4 = 0;
#pragma unroll 8
  for (int k = kg * 256; k < kg * 256 + 256; ++k) {
    float wv = w[(size_t)k * 6144];
    a0 += sc[k] * wv; a1 += sc[1024 + k] * wv; a2 += sc[2048 + k] * wv; a3 += sc[3072 + k] * wv; a4 += sc[4096 + k] * wv;
  }
  red[(kg * 5 + 0) * 64 + col] = a0; red[(kg * 5 + 1) * 64 + col] = a1; red[(kg * 5 + 2) * 64 + col] = a2;
  red[(kg * 5 + 3) * 64 + col] = a3; red[(kg * 5 + 4) * 64 + col] = a4;
  __syncthreads();
  float* mod = (float*)(p.ws + OFF_MOD);
  for (int e = tid; e < 320; e += 256) {
    int r = e >> 6, c = e & 63;
    float s = red[(0 * 5 + r) * 64 + c] + red[(1 * 5 + r) * 64 + c] + red[(2 * 5 + r) * 64 + c] + red[(3 * 5 + r) * 64 + c];
    mod[(layer * 5 + r) * 6144 + n0 + c] = s + p.in(5)[layer * 6144 + n0 + c];
  }
  __syncthreads();
}

DI void phase0(const PA& p, unsigned char* smem) {
  const int bid = vbid(), G = vgrid(), tid = vtid();
  const int gt = bid * 256 + tid;
  float* ropec = (float*)(p.ws + OFF_ROPE);
  float* ropes = ropec + 2048;
  if (gt < 2048) {
    const int e = gt;
    int pos = e >> 4, j = e & 15;
    float f = powf(10000.f, -(float)j / 16.f);
    float ang = (float)pos * f;
    float s, c;
    sincosf(ang, &s, &c);
    ropec[e] = c; ropes[e] = s;
  }
  f16* mu16 = (f16*)(p.ws + OFF_MU16);
  if (gt < 6144) mu16[gt] = (f16)p.in(15)[gt];
  for (int it = bid; it < 192; it += G) mod_item(p, it, smem);
  int base = 192;
  conv_job(p.in(10), 1024, 1536, (f16*)(p.ws + A_WQKV), 1024, base, smem);
  conv_job(p.in(14), 1024, 1024, (f16*)(p.ws + A_WO0), 1024, base, smem);
  conv_job(p.in(8), 1024, 4096, (f16*)(p.ws + A_W1_0), 1024, base, smem);
  conv_job(p.in(9), 4096, 1024, (f16*)(p.ws + A_W2_0), 4096, base, smem);
  for (int d = 0; d < 2; ++d) conv_job(p.in(19) + (size_t)d * 64 * 1024, 64, 1024, (f16*)(p.ws + OFF_W2DEC) + (size_t)d * 1024 * 64, 64, base, smem);
  conv_job(p.in(22), 64, 1024, (f16*)(p.ws + OFF_A2), 64, base, smem);
  for (int d = 0; d < 2; ++d) conv_job(p.in(24) + (size_t)d * 128 * 1024, 128, 1024, (f16*)(p.ws + OFF_G2) + (size_t)d * 1024 * 128, 128, base, smem);
  conv_job(p.in(30), 1024, 1024, (f16*)(p.ws + OFF_WO1), 1024, base, smem);
}

DI void phase_norm(const float* srcLat, const float* srcCtx, const float* g, const float* modl, int shidx, f16* dst, int ntok) {
  const int tid = vtid(), lane = tid & 63, wave = tid >> 6;
  for (int t4 = vbid(); t4 < (ntok >> 2); t4 += vgrid()) {
    const int tok = t4 * 4 + wave;
    const float* src = tok < T_LAT ? srcLat + (size_t)tok * 1024 : srcCtx + (size_t)(tok - T_LAT) * 1024;
    const int bi = tok < T_LAT ? (tok >> 13) : 4;
    const float* sh = modl + bi * 6144 + shidx * 1024;
    const float* sc = sh + 1024;
    float4 v[4];
    float ss = 0.f;
#pragma unroll
    for (int q = 0; q < 4; ++q) {
      v[q] = ((const float4*)src)[lane + 64 * q];
      ss += v[q].x * v[q].x + v[q].y * v[q].y + v[q].z * v[q].z + v[q].w * v[q].w;
    }
    ss = wave_sum(ss, lane);
    const float rs = rsqrtf(ss * (1.f / 1024.f) + 1e-6f);
#pragma unroll
    for (int q = 0; q < 4; ++q) {
      const int col = (lane + 64 * q) * 4;
      float4 g4 = *(const float4*)(g + col), s4 = *(const float4*)(sc + col), h4 = *(const float4*)(sh + col);
      float y0 = v[q].x * rs * g4.x * (1.f + s4.x) + h4.x;
      float y1 = v[q].y * rs * g4.y * (1.f + s4.y) + h4.y;
      float y2 = v[q].z * rs * g4.z * (1.f + s4.z) + h4.z;
      float y3 = v[q].w * rs * g4.w * (1.f + s4.w) + h4.w;
      *(uint2*)(dst + (size_t)tok * 1024 + col) = make_uint2(pack_h2(y0, y1), pack_h2(y2, y3));
    }
  }
}

DI void phase_shift(const PA& p, unsigned char* smem) {
  const int tid = vtid(), lane = tid & 63, wave = tid >> 6;
  float* red = (float*)smem;
  const float* modl = (const float*)(p.ws + OFF_MOD) + 5 * 6144;
  const float* g = p.in(6) + 1024;
  const float* xc = (const float*)(p.ws + OFF_XC);
  f16* H = (f16*)(p.ws + A_H);
  f16* XX = (f16*)(p.ws + A_XX);
  const int col = tid * 4;
  for (int ch = vbid(); ch < T_ALL / 8; ch += vgrid()) {
    const int t0 = ch * 8;
    int lo, hi, bi;
    if (t0 < T_LAT) { lo = (t0 >> 13) << 13; hi = lo + 8192; bi = t0 >> 13; }
    else { lo = T_LAT + (((t0 - T_LAT) >> 8) << 8); hi = lo + 256; bi = 4; }
    float4 x[10];
    float ss[10];
#pragma unroll
    for (int i = 0; i < 10; ++i) {
      const int tok = t0 - 1 + i;
      const bool ok = tok >= lo && tok < hi;
      if (ok) {
        const float* src = tok < T_LAT ? p.out + (size_t)tok * 1024 : xc + (size_t)(tok - T_LAT) * 1024;
        x[i] = *(const float4*)(src + col);
      } else x[i] = make_float4(0.f, 0.f, 0.f, 0.f);
      ss[i] = wave_sum(x[i].x * x[i].x + x[i].y * x[i].y + x[i].z * x[i].z + x[i].w * x[i].w, lane);
    }
    if (lane == 0) {
#pragma unroll
      for (int i = 0; i < 10; ++i) red[wave * 10 + i] = ss[i];
    }
    __syncthreads();
    const float* sh = modl + bi * 6144;
    float4 g4 = *(const float4*)(g + col), s4 = *(const float4*)(sh + 1024 + col), h4 = *(const float4*)(sh + col);
#pragma unroll
    for (int i = 0; i < 10; ++i) {
      const int tok = t0 - 1 + i;
      const bool ok = tok >= lo && tok < hi;
      const float tot = red[i] + red[10 + i] + red[20 + i] + red[30 + i];
      const float rs = rsqrtf(tot * (1.f / 1024.f) + 1e-6f);
      if (ok) {
        x[i].x = x[i].x * rs * g4.x * (1.f + s4.x) + h4.x;
        x[i].y = x[i].y * rs * g4.y * (1.f + s4.y) + h4.y;
        x[i].z = x[i].z * rs * g4.z * (1.f + s4.z) + h4.z;
        x[i].w = x[i].w * rs * g4.w * (1.f + s4.w) + h4.w;
      }
    }
#pragma unroll
    for (int i = 1; i <= 8; ++i) {
      const int tok = t0 - 1 + i;
      float a0 = 0.5f * (x[i - 1].x + x[i + 1].x) - x[i].x;
      float a1 = 0.5f * (x[i - 1].y + x[i + 1].y) - x[i].y;
      float a2 = 0.5f * (x[i - 1].z + x[i + 1].z) - x[i].z;
      float a3 = 0.5f * (x[i - 1].w + x[i + 1].w) - x[i].w;
      *(uint2*)(H + (size_t)tok * 1024 + col) = make_uint2(pack_h2(x[i].x, x[i].y), pack_h2(x[i].z, x[i].w));
      *(uint2*)(XX + (size_t)tok * 1024 + col) = make_uint2(pack_h2(a0, a1), pack_h2(a2, a3));
    }
    __syncthreads();
  }
}

DI uint4 hfma8(uint4 x, uint4 m, uint4 a) {
  uint4 r;
  r.x = __builtin_bit_cast(unsigned, (f16x2)(__builtin_bit_cast(f16x2, x.x) * __builtin_bit_cast(f16x2, m.x) + __builtin_bit_cast(f16x2, a.x)));
  r.y = __builtin_bit_cast(unsigned, (f16x2)(__builtin_bit_cast(f16x2, x.y) * __builtin_bit_cast(f16x2, m.y) + __builtin_bit_cast(f16x2, a.y)));
  r.z = __builtin_bit_cast(unsigned, (f16x2)(__builtin_bit_cast(f16x2, x.z) * __builtin_bit_cast(f16x2, m.z) + __builtin_bit_cast(f16x2, a.z)));
  r.w = __builtin_bit_cast(unsigned, (f16x2)(__builtin_bit_cast(f16x2, x.w) * __builtin_bit_cast(f16x2, m.w) + __builtin_bit_cast(f16x2, a.w)));
  return r;
}

template <bool MIX>
DI void gemm_mainloop(f32x4 (&acc)[4][4], const f16* __restrict__ A, int lda, const f16* __restrict__ XXp, const f16* __restrict__ mu,
                      const f16* __restrict__ Bt, int ldb, int K, unsigned char* smem) {
  const int tid = vtid(), lane = tid & 63, wave = tid >> 6;
  const int wm = wave >> 1, wn = wave & 1;
  const int lr = tid >> 3, lc = (tid & 7) * 8;
  f16* sA = (f16*)smem;
  f16* sB = sA + 2 * 128 * 72;
#pragma unroll
  for (int i = 0; i < 4; ++i)
#pragma unroll
    for (int j = 0; j < 4; ++j) acc[i][j] = (f32x4){0.f, 0.f, 0.f, 0.f};
  uint4 ra0, ra1, ra2, ra3, rb0, rb1, rb2, rb3;
  const f16* Ap = A + (size_t)lr * lda + lc;
  const f16* Xp = MIX ? XXp + (size_t)lr * lda + lc : nullptr;
  const f16* Bp = Bt + (size_t)lr * ldb + lc;
#define GL1(RA, RB, P, K0)                                                         \
  {                                                                                \
    uint4 a_ = *(const uint4*)(Ap + (size_t)(32 * (P)) * lda + (K0));              \
    if (MIX) {                                                                     \
      uint4 x_ = *(const uint4*)(Xp + (size_t)(32 * (P)) * lda + (K0));            \
      uint4 m_ = *(const uint4*)(mu + (K0) + lc);                                  \
      a_ = hfma8(x_, m_, a_);                                                      \
    }                                                                              \
    RA = a_;                                                                       \
    RB = *(const uint4*)(Bp + (size_t)(32 * (P)) * ldb + (K0));                    \
  }
#define gload(K0) { GL1(ra0, rb0, 0, K0) GL1(ra1, rb1, 1, K0) GL1(ra2, rb2, 2, K0) GL1(ra3, rb3, 3, K0) }
#define SW1(RA, RB, P, BUF)                                                        \
  {                                                                                \
    *(uint4*)(sA + ((BUF) * 128 + lr + 32 * (P)) * 72 + lc) = RA;                  \
    *(uint4*)(sB + ((BUF) * 128 + lr + 32 * (P)) * 72 + lc) = RB;                  \
  }
#define swrite(BUF) { SW1(ra0, rb0, 0, BUF) SW1(ra1, rb1, 1, BUF) SW1(ra2, rb2, 2, BUF) SW1(ra3, rb3, 3, BUF) }
  gload(0);
  swrite(0);
  __syncthreads();
  const int nk = K >> 6;
  for (int kt = 0; kt < nk; ++kt) {
    const int cur = kt & 1;
    if (kt + 1 < nk) gload((kt + 1) * 64);
    const f16* a_base = sA + (cur * 128 + wm * 64 + (lane & 15)) * 72 + (lane >> 4) * 8;
    const f16* b_base = sB + (cur * 128 + wn * 64 + (lane & 15)) * 72 + (lane >> 4) * 8;
#pragma unroll
    for (int ks = 0; ks < 2; ++ks) {
      f16x8 af[4], bfr[4];
#pragma unroll
      for (int mt = 0; mt < 4; ++mt) af[mt] = *(const f16x8*)(a_base + mt * 16 * 72 + ks * 32);
#pragma unroll
      for (int nt = 0; nt < 4; ++nt) bfr[nt] = *(const f16x8*)(b_base + nt * 16 * 72 + ks * 32);
#pragma unroll
      for (int mt = 0; mt < 4; ++mt)
#pragma unroll
        for (int nt = 0; nt < 4; ++nt) acc[mt][nt] = __builtin_amdgcn_mfma_f32_16x16x32_f16(af[mt], bfr[nt], acc[mt][nt], 0, 0, 0);
    }
    if (kt + 1 < nk) swrite(cur ^ 1);
    __syncthreads();
  }
}

#undef gload
#undef swrite
#undef GL1
#undef SW1

DI void stage_c(const f32x4 (&acc)[4][4], unsigned char* smem) {
  float* sC = (float*)smem;
  const int tid = vtid(), lane = tid & 63, wave = tid >> 6;
  const int wm = wave >> 1, wn = wave & 1, g = lane >> 4, c = lane & 15;
#pragma unroll
  for (int mt = 0; mt < 4; ++mt)
#pragma unroll
    for (int nt = 0; nt < 4; ++nt)
#pragma unroll
      for (int i = 0; i < 4; ++i) sC[(wm * 64 + mt * 16 + g * 4 + i) * 132 + wn * 64 + nt * 16 + c] = acc[mt][nt][i];
  __syncthreads();
}

DI void epi_qkv(const PA& p, int m, int n, const float* cr, int row, int half) {
  const int tok = m * 128 + row, hd = n * 2 + half;
  if (hd < 20) {
    const float* gain = hd < 16 ? p.in(11) : p.in(12);
    float ss = 0.f;
#pragma unroll
    for (int c4 = 0; c4 < 16; ++c4) {
      float4 t = *(const float4*)(cr + c4 * 4);
      ss += t.x * t.x + t.y * t.y + t.z * t.z + t.w * t.w;
    }
    const float rs = rsqrtf(ss * (1.f / 64.f) + 1e-6f);
    const bool lat = tok < T_LAT;
    const int s = tok & 8191;
    const float* ropec = (const float*)(p.ws + OFF_ROPE);
    const float* ropes = ropec + 2048;
    f16* dst = hd < 16 ? (f16*)(p.ws + A_Q) + (size_t)tok * 1024 + hd * 64 : (f16*)(p.ws + A_K) + (size_t)tok * 256 + (hd - 16) * 64;
#pragma unroll
    for (int hh = 0; hh < 2; ++hh) {
      const int pos = hh ? (s & 63) : (s >> 6);
#pragma unroll
      for (int j4 = 0; j4 < 4; ++j4) {
        const int c0 = hh * 32 + j4 * 4;
        float4 t1 = *(const float4*)(cr + c0), t2 = *(const float4*)(cr + c0 + 16);
        float4 g1 = *(const float4*)(gain + c0), g2 = *(const float4*)(gain + c0 + 16);
        t1.x *= rs * g1.x; t1.y *= rs * g1.y; t1.z *= rs * g1.z; t1.w *= rs * g1.w;
        t2.x *= rs * g2.x; t2.y *= rs * g2.y; t2.z *= rs * g2.z; t2.w *= rs * g2.w;
        float4 o1 = t1, o2 = t2;
        if (lat) {
          float4 cc = *(const float4*)(ropec + pos * 16 + j4 * 4), sn = *(const float4*)(ropes + pos * 16 + j4 * 4);
          o1.x = t1.x * cc.x - t2.x * sn.x; o2.x = t1.x * sn.x + t2.x * cc.x;
          o1.y = t1.y * cc.y - t2.y * sn.y; o2.y = t1.y * sn.y + t2.y * cc.y;
          o1.z = t1.z * cc.z - t2.z * sn.z; o2.z = t1.z * sn.z + t2.z * cc.z;
          o1.w = t1.w * cc.w - t2.w * sn.w; o2.w = t1.w * sn.w + t2.w * cc.w;
        }
        *(uint2*)(dst + c0) = make_uint2(pack_h2(o1.x, o1.y), pack_h2(o1.z, o1.w));
        *(uint2*)(dst + c0 + 16) = make_uint2(pack_h2(o2.x, o2.y), pack_h2(o2.z, o2.w));
      }
    }
  } else {
    const int kvh = hd - 20;
    int b, tpos;
    if (tok < T_LAT) { b = tok >> 13; tpos = tok & 8191; } else { b = (tok - T_LAT) >> 8; tpos = 8192 + ((tok - T_LAT) & 255); }
    u16* base = (u16*)(p.ws + A_VT) + (size_t)((b * 4 + kvh) * 64) * 8448 + tpos;
#pragma unroll 8
    for (int c = 0; c < 64; ++c) base[(size_t)c * 8448] = __builtin_bit_cast(u16, (f16)cr[c]);
  }
}

DI void epi_res(const GemmArgs& ga, int m, int n, const float* cr, int row, int half) {
  const int tok = m * 128 + row, col0 = n * 128 + half * 64;
  const float* src; float* dst; int bi;
  if (tok < T_LAT) { src = ga.srcLat + (size_t)tok * 1024; dst = ga.dstLat + (size_t)tok * 1024; bi = tok >> 13; }
  else { src = ga.srcCtx + (size_t)(tok - T_LAT) * 1024; dst = ga.dstCtx + (size_t)(tok - T_LAT) * 1024; bi = 4; }
  const float* gt = ga.gt + bi * 6144;
#pragma unroll 4
  for (int c4 = 0; c4 < 16; ++c4) {
    float4 a = *(const float4*)(cr + c4 * 4);
    float4 x = *(const float4*)(src + col0 + c4 * 4);
    float4 g = *(const float4*)(gt + col0 + c4 * 4);
    float4 o = make_float4(x.x + g.x * a.x, x.y + g.y * a.y, x.z + g.z * a.z, x.w + g.w * a.w);
    *(float4*)(dst + col0 + c4 * 4) = o;
  }
}

DI void epi_mlp1(const GemmArgs& ga, int m, int n, const float* cr, int row, int half) {
  const int tok = m * 128 + row, col0 = n * 128 + half * 64;
  f16* dst = ga.dstH + (size_t)tok * 4096 + col0;
#pragma unroll 2
  for (int q = 0; q < 8; ++q) {
    float4 a = *(const float4*)(cr + q * 8), b = *(const float4*)(cr + q * 8 + 4);
    a.x = fmaxf(a.x, 0.f); a.y = fmaxf(a.y, 0.f); a.z = fmaxf(a.z, 0.f); a.w = fmaxf(a.w, 0.f);
    b.x = fmaxf(b.x, 0.f); b.y = fmaxf(b.y, 0.f); b.z = fmaxf(b.z, 0.f); b.w = fmaxf(b.w, 0.f);
    *(uint4*)(dst + q * 8) = make_uint4(pack_h2(a.x * a.x, a.y * a.y), pack_h2(a.z * a.z, a.w * a.w),
                                        pack_h2(b.x * b.x, b.y * b.y), pack_h2(b.z * b.z, b.w * b.w));
  }
}

DI void epi_b2(const PA& p, int m, int n, const float* cr, int row, int half) {
  const int tok = m * 128 + row, head = n * 2 + half, ch0 = head * 64;
  f16* Kp = (f16*)(p.ws + A_KP) + (size_t)tok * 1024 + ch0;
  const f16* Rp = (const f16*)(p.ws + A_R) + (size_t)tok * 1024 + ch0;
  f16* KK = (f16*)(p.ws + A_KKN) + (size_t)tok * 1024 + ch0;
  f16* BV = (f16*)(p.ws + A_BV) + (size_t)tok * 1024 + ch0;
  const float* k_k = p.in(25) + ch0; const float* k_a = p.in(26) + ch0; const float* r_k = p.in(27) + ch0; const float* a0 = p.in(20) + ch0;
  f16x8 kv[8];
  float ss = 0.f;
#pragma unroll
  for (int q = 0; q < 8; ++q) {
    kv[q] = *(const f16x8*)(Kp + q * 8);
#pragma unroll
    for (int e = 0; e < 8; ++e) { float t = (float)kv[q][e] * k_k[q * 8 + e]; ss += t * t; }
  }
  const float inv = 1.f / fmaxf(sqrtf(ss), 1e-12f);
  float rk = 0.f;
#pragma unroll
  for (int q = 0; q < 8; ++q) {
    f16x8 rv = *(const f16x8*)(Rp + q * 8);
    float kk[8], bv[8], kp[8];
#pragma unroll
    for (int e = 0; e < 8; ++e) {
      const int c = q * 8 + e;
      const float kr = (float)kv[q][e];
      const float al = sigmoidf_(a0[c] + cr[c]);
      kk[e] = kr * k_k[c] * inv;
      bv[e] = kk[e] * al;
      kp[e] = kr * (1.f + (al - 1.f) * k_a[c]);
      rk += (float)rv[e] * kp[e] * r_k[c];
    }
    *(uint4*)(KK + q * 8) = make_uint4(pack_h2(kk[0], kk[1]), pack_h2(kk[2], kk[3]), pack_h2(kk[4], kk[5]), pack_h2(kk[6], kk[7]));
    *(uint4*)(BV + q * 8) = make_uint4(pack_h2(bv[0], bv[1]), pack_h2(bv[2], bv[3]), pack_h2(bv[4], bv[5]), pack_h2(bv[6], bv[7]));
    *(uint4*)(Kp + q * 8) = make_uint4(pack_h2(kp[0], kp[1]), pack_h2(kp[2], kp[3]), pack_h2(kp[4], kp[5]), pack_h2(kp[6], kp[7]));
  }
  ((float*)(p.ws + OFF_RK))[(size_t)tok * 16 + head] = rk;
}

DI void epi_feat(const PA& p, int m, int n, const float* cr, int row, int half) {
  const int tok = m * 128 + row;
  size_t off; int mode;
  if (n < 24) { off = (n < 8 ? A_R : (n < 16 ? A_KP : A_V)) + ((size_t)tok * 1024 + (n & 7) * 128 + half * 64) * 2; mode = 0; }
  else if (n == 24) { off = A_TW + ((size_t)tok * 128 + half * 64) * 2; mode = 1; }
  else if (n == 25) { off = A_AI + ((size_t)tok * 64) * 2; mode = half == 0 ? 0 : 3; }
  else { off = A_G + ((size_t)tok * 256 + (n - 26) * 128 + half * 64) * 2; mode = 2; }
  if (mode == 3) return;
  f16* dst = (f16*)(p.ws + off);
#pragma unroll 2
  for (int q = 0; q < 8; ++q) {
    float4 a = *(const float4*)(cr + q * 8), b = *(const float4*)(cr + q * 8 + 4);
    if (mode == 1) {
      a.x = tanhf_(a.x); a.y = tanhf_(a.y); a.z = tanhf_(a.z); a.w = tanhf_(a.w);
      b.x = tanhf_(b.x); b.y = tanhf_(b.y); b.z = tanhf_(b.z); b.w = tanhf_(b.w);
    } else if (mode == 2) {
      a.x = sigmoidf_(a.x); a.y = sigmoidf_(a.y); a.z = sigmoidf_(a.z); a.w = sigmoidf_(a.w);
      b.x = sigmoidf_(b.x); b.y = sigmoidf_(b.y); b.z = sigmoidf_(b.z); b.w = sigmoidf_(b.w);
    }
    *(uint4*)(dst + q * 8) = make_uint4(pack_h2(a.x, a.y), pack_h2(a.z, a.w), pack_h2(b.x, b.y), pack_h2(b.z, b.w));
  }
}

template <int EPI>
DI void gemm_phase(const PA& p, const GemmArgs& ga, unsigned char* smem, int m0 = 0, const f16* XXp = nullptr, const f16* mu16 = nullptr) {
  const int tid = vtid(), row = tid >> 1, half = tid & 1;
  const float* cr = (const float*)smem + row * 132 + half * 64;
  const int ntile = ga.MT * ga.NT;
  for (int t = vbid(); t < ntile; t += vgrid()) {
    const int mi = t / ga.NT, n = t - mi * ga.NT, m = m0 + mi;
    f32x4 acc[4][4];
    if (EPI == EPI_FEAT) {
      const int mx = n < 8 ? 0 : (n < 16 ? 2 : (n < 24 ? 3 : (n == 24 ? 1 : (n == 25 ? 4 : 5))));
      gemm_mainloop<true>(acc, ga.A + (size_t)m * 128 * ga.lda, ga.lda, XXp + (size_t)m * 128 * ga.lda, mu16 + mx * 1024, ga.Bt + (size_t)n * 128 * ga.ldb, ga.ldb, ga.K, smem);
    } else {
      gemm_mainloop<false>(acc, ga.A + (size_t)m * 128 * ga.lda, ga.lda, nullptr, nullptr, ga.Bt + (size_t)n * 128 * ga.ldb, ga.ldb, ga.K, smem);
    }
    stage_c(acc, smem);
    if (EPI == EPI_QKV) epi_qkv(p, m, n, cr, row, half);
    else if (EPI == EPI_RES) epi_res(ga, m, n, cr, row, half);
    else if (EPI == EPI_MLP1) epi_mlp1(ga, m, n, cr, row, half);
    else if (EPI == EPI_FEAT) epi_feat(p, m, n, cr, row, half);
    else epi_b2(p, m, n, cr, row, half);
    __syncthreads();
  }
}

constexpr int G_HT = 128 * 64;
DI int lds_byte(int r, int c) {
  int st = (r >> 4) * 2 + (c >> 5), rr = r & 15, cc = c & 31, ob = rr * 64 + cc * 2;
  return st * 1024 + (ob ^ (((ob >> 9) & 1) << 5));
}
DI void stage_rc(int b, int& R, int& C) {
  int st = b / 1024, sb = b % 1024, swz = sb ^ (((sb >> 9) & 1) << 5);
  R = (st >> 1) * 16 + swz / 64; C = (st & 1) * 32 + (swz % 64) / 2;
}
DI int perm32(int rho) { const int n = rho >> 4, i = rho & 15; return 8 * (i >> 2) + 4 * n + (i & 3); }
DI bool unit_next(int i, int G, int c, int nM, int nN, int& pm, int& pn) {
  const int nwg = nM * nN;
  const long L = (long)i * G + c;
  if (L >= nwg) return false;
  int wgid = (int)L;
  { const int q = nwg / 8, r = nwg % 8, xcd = wgid % 8, off = wgid / 8; wgid = (xcd < r ? xcd * (q + 1) : r * (q + 1) + (xcd - r) * q) + off; }
  const int nig = 8 * nN, gid = wgid / nig, fm = gid * 8, gsz = (nM - fm) < 8 ? (nM - fm) : 8;
  pm = fm + ((wgid % nig) % gsz); pn = (wgid % nig) / gsz;
  return true;
}
struct BigArgs {
  const f16* A1; const f16* A2; const f16* Bt; int lda, ldb, nk1, nt, nM, nN;
  GemmArgs e;
};

template <int EPI>
DI void gemm256_phase(const PA& p, const BigArgs& ga, unsigned char* smem) {
  typedef __attribute__((address_space(3))) unsigned char* LdsP;
  LdsP lds = (LdsP)smem;
  const int tid = opaque_tid();
  const int wid = __builtin_amdgcn_readfirstlane(tid >> 6), lane = tid & 63, wr = wid >> 2, wc = wid & 3, fr = lane & 15, fq = lane >> 4;
  const int lda = ga.lda, ldb = ga.ldb, nk1 = ga.nk1, nt = ga.nt;
  const int cid = __builtin_amdgcn_readfirstlane((int)*(volatile __attribute__((address_space(3))) unsigned*)(smem + 2 * LDS_HALF + 12));
  unsigned oa0, oa1, ob0, ob1;
  { int R, C; stage_rc(tid * 16, R, C); oa0 = (unsigned)(R * lda + C) * 2u; ob0 = (unsigned)(R * ldb + C) * 2u;
    stage_rc(tid * 16 + 8192, R, C); oa1 = (unsigned)(R * lda + C) * 2u; ob1 = (unsigned)(R * ldb + C) * 2u; }
  const unsigned ldsw = (unsigned)wid * 1024u;
  const int aoff = lds_byte(wr * 64 + fr, fq * 8), boff = lds_byte(wc * 32 + fr, fq * 8);
#define SA(b, h) (((b) * 2 + (h)) * 16384)
#define SB(b, h) ((4 + (b) * 2 + (h)) * 16384)
#define LDSU(x) ((__attribute__((address_space(3))) unsigned*)(x))
#define STAGE_A(P, br, kt)                                                                                             \
  do {                                                                                                                 \
    const char* base_ = (const char*)(ga.A1 + (long)(br) * lda + (long)(kt) * 64);          \
    __builtin_amdgcn_global_load_lds((const unsigned*)(base_ + oa0), LDSU(lds + (P) + ldsw), 16, 0, 0);                \
    __builtin_amdgcn_global_load_lds((const unsigned*)(base_ + oa1), LDSU(lds + (P) + ldsw + 8192), 16, 0, 0);         \
  } while (0)
#define STAGE_B(P, br, kt)                                                                                             \
  do {                                                                                                                 \
    const char* base_ = (const char*)(ga.Bt + (long)(br) * ldb + (long)(kt) * 64);                                     \
    __builtin_amdgcn_global_load_lds((const unsigned*)(base_ + ob0), LDSU(lds + (P) + ldsw), 16, 0, 0);                \
    __builtin_amdgcn_global_load_lds((const unsigned*)(base_ + ob1), LDSU(lds + (P) + ldsw + 8192), 16, 0, 0);         \
  } while (0)
#define LDA(dst, b, h)            \
  for (int m = 0; m < 4; ++m)     \
    for (int k = 0; k < 2; ++k) dst[m][k] = *(const __attribute__((address_space(3))) f16x8*)(lds + SA(b, h) + aoff + m * 2048 + k * 1024)
#define LDB(dst, b, h)            \
  for (int n = 0; n < 2; ++n)     \
    for (int k = 0; k < 2; ++k) dst[n][k] = *(const __attribute__((address_space(3))) f16x8*)(lds + SB(b, h) + boff + n * 2048 + k * 1024)
#define MMA(ai, bj, At_, Bt_)                                                                                          \
  do {                                                                                                                 \
    __builtin_amdgcn_s_setprio(1);                                                                                     \
    for (int m = 0; m < 4; ++m)                                                                                        \
      for (int n = 0; n < 2; ++n)                                                                                      \
        for (int k = 0; k < 2; ++k) acc[ai][bj][m][n] = __builtin_amdgcn_mfma_f32_16x16x32_f16(At_[m][k], Bt_[n][k], acc[ai][bj][m][n], 0, 0, 0); \
    __builtin_amdgcn_s_setprio(0);                                                                                     \
  } while (0)
#define WAIT_V(n) asm volatile("s_waitcnt vmcnt(" #n ")" ::: "memory")
#define WAIT_L(n) asm volatile("s_waitcnt lgkmcnt(" #n ")" ::: "memory")
#define BAR __builtin_amdgcn_s_barrier()
#define SCHED __builtin_amdgcn_sched_barrier(0)
  for (int ui = 0;; ++ui) {
    int pm, pn;
    if (!unit_next(ui, (int)gridDim.x, cid, ga.nM, ga.nN, pm, pn)) break;
    const int brow = pm * 256, bcol = pn * 256;
    f32x4 acc[2][2][4][2];
#pragma unroll
    for (int a = 0; a < 2; ++a)
#pragma unroll
      for (int b = 0; b < 2; ++b)
#pragma unroll
        for (int m = 0; m < 4; ++m)
#pragma unroll
          for (int n = 0; n < 2; ++n) acc[a][b][m][n] = (f32x4){0.f, 0.f, 0.f, 0.f};
    f16x8 At[4][2], B0[2][2], B1[2][2];
    STAGE_B(SB(0, 0), bcol, 0); STAGE_A(SA(0, 0), brow, 0);
    STAGE_B(SB(0, 1), bcol + 128, 0); STAGE_A(SA(0, 1), brow + 128, 0);
    if (wr == 1) BAR;
    WAIT_V(4); BAR;
    STAGE_B(SB(1, 0), bcol, 1); STAGE_A(SA(1, 0), brow, 1); STAGE_B(SB(1, 1), bcol + 128, 1);
    WAIT_V(6); BAR;
    for (int t = 0; t < nt - 2; t += 2) {
      LDB(B0, 0, 0); SCHED; LDA(At, 0, 0); STAGE_A(SA(1, 1), brow + 128, t + 1);
      WAIT_L(8); BAR; WAIT_L(0); MMA(0, 0, At, B0); BAR; SCHED;
      LDB(B1, 0, 1); STAGE_B(SB(0, 0), bcol, t + 2);
      BAR; WAIT_L(0); MMA(0, 1, At, B1); BAR;
      LDA(At, 0, 1); STAGE_A(SA(0, 0), brow, t + 2);
      BAR; WAIT_L(0); MMA(1, 0, At, B0); BAR; SCHED;
      STAGE_B(SB(0, 1), bcol + 128, t + 2);
      WAIT_V(6); BAR; MMA(1, 1, At, B1); BAR;
      LDB(B0, 1, 0); SCHED; LDA(At, 1, 0); STAGE_A(SA(0, 1), brow + 128, t + 2);
      WAIT_L(8); BAR; WAIT_L(0); MMA(0, 0, At, B0); BAR; SCHED;
      LDB(B1, 1, 1); STAGE_B(SB(1, 0), bcol, t + 3);
      BAR; WAIT_L(0); MMA(0, 1, At, B1); BAR;
      LDA(At, 1, 1); STAGE_A(SA(1, 0), brow, t + 3);
      BAR; WAIT_L(0); MMA(1, 0, At, B0); BAR; SCHED;
      STAGE_B(SB(1, 1), bcol + 128, t + 3);
      WAIT_V(6); BAR; MMA(1, 1, At, B1); BAR;
    }
    { LDB(B0, 0, 0); LDA(At, 0, 0); STAGE_A(SA(1, 1), brow + 128, nt - 1);
      BAR; WAIT_L(0); MMA(0, 0, At, B0); BAR;
      LDB(B1, 0, 1); BAR; WAIT_L(0); MMA(0, 1, At, B1); BAR;
      LDA(At, 0, 1); WAIT_V(4); BAR; WAIT_L(0); MMA(1, 0, At, B0); MMA(1, 1, At, B1); BAR; }
    { LDB(B0, 1, 0); LDA(At, 1, 0); WAIT_V(2); BAR; WAIT_L(0); MMA(0, 0, At, B0); BAR;
      LDB(B1, 1, 1); WAIT_V(0); BAR; WAIT_L(0); MMA(0, 1, At, B1); BAR;
      LDA(At, 1, 1); BAR; WAIT_L(0); MMA(1, 0, At, B0); MMA(1, 1, At, B1); BAR; }
    if (wr == 0) BAR;
    __syncthreads();
    float* sC = (float*)smem;
    const int tid2 = opaque_tid();
    const int vb = tid2 >> 8, vt = tid2 & 255, erow = vt >> 1, ehalf = vt & 1;
    const int sc_base = (wr * 64 + ((tid2 & 63) >> 4) * 4) * 132 + wc * 32 + (tid2 & 15);
    const float* cr = sC + vb * (128 * 132) + erow * 132 + ehalf * 64;
#pragma unroll
    for (int ai = 0; ai < 2; ++ai) {
#pragma unroll
      for (int bj = 0; bj < 2; ++bj)
#pragma unroll
        for (int m = 0; m < 4; ++m)
#pragma unroll
          for (int n = 0; n < 2; ++n)
#pragma unroll
            for (int j = 0; j < 4; ++j) sC[sc_base + bj * (128 * 132) + (m * 16 + j) * 132 + n * 16] = acc[ai][bj][m][n][j];
      __syncthreads();
      const int em = pm * 2 + ai, en = pn * 2 + vb;
      if (EPI == EPI_QKV) epi_qkv(p, em, en, cr, erow, ehalf);
      else if (EPI == EPI_RES) epi_res(ga.e, em, en, cr, erow, ehalf);
      else if (EPI == EPI_MLP1) epi_mlp1(ga.e, em, en, cr, erow, ehalf);
      else epi_feat(p, em, en, cr, erow, ehalf);
      __syncthreads();
    }
  }
#undef SA
#undef SB
#undef LDSU
#undef STAGE_A
#undef STAGE_B
#undef LDA
#undef LDB
#undef MMA
}

template <int EPI>
DI void epi_direct(const PA& p, const BigArgs& ga, const f32x4 (&acc)[2][2][4][2], int pm, int pn, int wr, int wc, int fr, int fq) {
  const int row0 = pm * 256 + wr * 64 + fr, col0 = pn * 256 + wc * 32 + fq * 8;
  if (EPI == EPI_MLP1) {
    f16* U = ga.e.dstH;
#pragma unroll
    for (int ai = 0; ai < 2; ++ai)
#pragma unroll
      for (int m = 0; m < 4; ++m) {
        f16* rp = U + (size_t)(row0 + ai * 128 + m * 16) * 4096 + col0;
#pragma unroll
        for (int bj = 0; bj < 2; ++bj) {
          const f32x4 v0 = acc[ai][bj][m][0], v1 = acc[ai][bj][m][1];
          const float a0 = fmaxf(v0[0], 0.f), a1 = fmaxf(v0[1], 0.f), a2 = fmaxf(v0[2], 0.f), a3 = fmaxf(v0[3], 0.f);
          const float b0 = fmaxf(v1[0], 0.f), b1 = fmaxf(v1[1], 0.f), b2 = fmaxf(v1[2], 0.f), b3 = fmaxf(v1[3], 0.f);
          typedef unsigned u32x4_t __attribute__((ext_vector_type(4)));
          const u32x4_t pk_ = {pack_h2(a0 * a0, a1 * a1), pack_h2(a2 * a2, a3 * a3), pack_h2(b0 * b0, b1 * b1), pack_h2(b2 * b2, b3 * b3)};
          __builtin_nontemporal_store(pk_, (u32x4_t*)(rp + bj * 128));
        }
      }
  } else if (EPI == EPI_RES) {
    const bool lat = pm < 128;
    const float* src = lat ? ga.e.srcLat : ga.e.srcCtx;
    float* dst = lat ? ga.e.dstLat : ga.e.dstCtx;
    const int rbase = lat ? row0 : row0 - T_LAT;
    const float* gt = ga.e.gt + (lat ? (pm >> 5) : 4) * 6144 + col0;
#pragma unroll
    for (int bj = 0; bj < 2; ++bj) {
      const f32x4 g0 = *(const f32x4*)(gt + bj * 128), g1 = *(const f32x4*)(gt + bj * 128 + 4);
#pragma unroll
      for (int ai = 0; ai < 2; ++ai)
#pragma unroll
        for (int m = 0; m < 4; ++m) {
          const size_t o = (size_t)(rbase + ai * 128 + m * 16) * 1024 + col0 + bj * 128;
          const f32x4 x0 = *(const f32x4*)(src + o), x1 = *(const f32x4*)(src + o + 4);
          *(f32x4*)(dst + o) = x0 + g0 * acc[ai][bj][m][0];
          *(f32x4*)(dst + o + 4) = x1 + g1 * acc[ai][bj][m][1];
        }
    }
  } else {
#pragma unroll
    for (int bj = 0; bj < 2; ++bj) {
      const int n128 = pn * 2 + bj;
      unsigned base; int ld, mode;
      if (n128 < 24) { base = (n128 < 8 ? A_R : (n128 < 16 ? A_KP : A_V)) + (unsigned)((n128 & 7) * 128) * 2u; ld = 1024; mode = 0; }
      else if (n128 == 24) { base = A_TW; ld = 128; mode = 1; }
      else if (n128 == 25) { base = A_AI; ld = 64; mode = 0; }
      else { base = A_G + (unsigned)((n128 - 26) * 128) * 2u; ld = 256; mode = 2; }
      if (n128 == 25 && wc >= 2) continue;
      f16* dp = (f16*)(p.ws + base) + wc * 32 + fq * 8;
#pragma unroll
      for (int ai = 0; ai < 2; ++ai)
#pragma unroll
        for (int m = 0; m < 4; ++m) {
          f32x4 v0 = acc[ai][bj][m][0], v1 = acc[ai][bj][m][1];
          if (mode == 1) {
            v0[0] = tanhf_(v0[0]); v0[1] = tanhf_(v0[1]); v0[2] = tanhf_(v0[2]); v0[3] = tanhf_(v0[3]);
            v1[0] = tanhf_(v1[0]); v1[1] = tanhf_(v1[1]); v1[2] = tanhf_(v1[2]); v1[3] = tanhf_(v1[3]);
          } else if (mode == 2) {
            v0[0] = sigmoidf_(v0[0]); v0[1] = sigmoidf_(v0[1]); v0[2] = sigmoidf_(v0[2]); v0[3] = sigmoidf_(v0[3]);
            v1[0] = sigmoidf_(v1[0]); v1[1] = sigmoidf_(v1[1]); v1[2] = sigmoidf_(v1[2]); v1[3] = sigmoidf_(v1[3]);
          }
          *(uint4*)(dp + (size_t)(row0 + ai * 128 + m * 16) * ld) = make_uint4(pack_h2(v0[0], v0[1]), pack_h2(v0[2], v0[3]), pack_h2(v1[0], v1[1]), pack_h2(v1[2], v1[3]));
        }
    }
  }
}

template <int EPI>
DI void gemm256s_phase(const PA& p, const BigArgs& ga, unsigned char* smem) {
  typedef __attribute__((address_space(3))) unsigned char* LdsP;
  LdsP lds = (LdsP)smem;
  const int tid = opaque_tid();
  const int wid = __builtin_amdgcn_readfirstlane(tid >> 6), lane = tid & 63, wr = wid >> 2, wc = wid & 3, fr = lane & 15, fq = lane >> 4;
  const int lda = ga.lda, ldb = ga.ldb, nk1 = ga.nk1, nt = ga.nt;
  const int cid = __builtin_amdgcn_readfirstlane((int)*(volatile __attribute__((address_space(3))) unsigned*)(smem + 2 * LDS_HALF + 12));
  unsigned oa0, oa1, ob0, ob1;
  { int R, C; stage_rc(tid * 16, R, C); oa0 = (unsigned)(R * lda + C) * 2u; ob0 = (unsigned)(((R & ~31) + perm32(R & 31)) * ldb + C) * 2u;
    stage_rc(tid * 16 + 8192, R, C); oa1 = (unsigned)(R * lda + C) * 2u; ob1 = (unsigned)(((R & ~31) + perm32(R & 31)) * ldb + C) * 2u; }
  const unsigned ldsw = (unsigned)wid * 1024u;
  const int aoff = lds_byte(wr * 64 + fr, fq * 8), boff = lds_byte(wc * 32 + fr, fq * 8);
  const size_t hstepA = (size_t)128 * lda * 2, hstepB = (size_t)128 * ldb * 2;
#define SA(b, h) (((b) * 2 + (h)) * 16384)
#define SB(b, h) ((4 + (b) * 2 + (h)) * 16384)
#define LDSU(x) ((__attribute__((address_space(3))) unsigned*)(x))
#define UNIT_BASES(pm_, pn_, a1b, a2b, bb)                                                      \
  const char* a1b = (const char*)ga.A1 + (size_t)(pm_) * (2 * hstepA);                          \
  const char* a2b = (const char*)ga.A2 + (size_t)(pm_) * (2 * hstepA) - (size_t)nk1 * 128;      \
  const char* bb = (const char*)ga.Bt + (size_t)(pn_) * (2 * hstepB);
#define APTR(a1b, a2b, kt_) (((kt_) < nk1 ? (a1b) : (a2b)) + (size_t)(kt_) * 128)
#define BPTR(bb, kt_) ((bb) + (size_t)(kt_) * 128)
#define STAGE_A(P, base_)                                                                                    \
  do {                                                                                                       \
    __builtin_amdgcn_global_load_lds((const unsigned*)((base_) + oa0), LDSU(lds + (P) + ldsw), 16, 0, 0);    \
    __builtin_amdgcn_global_load_lds((const unsigned*)((base_) + oa1), LDSU(lds + (P) + ldsw + 8192), 16, 0, 0); \
  } while (0)
#define STAGE_B(P, base_)                                                                                    \
  do {                                                                                                       \
    __builtin_amdgcn_global_load_lds((const unsigned*)((base_) + ob0), LDSU(lds + (P) + ldsw), 16, 0, 0);    \
    __builtin_amdgcn_global_load_lds((const unsigned*)((base_) + ob1), LDSU(lds + (P) + ldsw + 8192), 16, 0, 0); \
  } while (0)
#define LDA(dst, b, h)            \
  for (int m = 0; m < 4; ++m)     \
    for (int k = 0; k < 2; ++k) dst[m][k] = *(const __attribute__((address_space(3))) f16x8*)(lds + SA(b, h) + aoff + m * 2048 + k * 1024)
#define LDB(dst, b, h)            \
  for (int n = 0; n < 2; ++n)     \
    for (int k = 0; k < 2; ++k) dst[n][k] = *(const __attribute__((address_space(3))) f16x8*)(lds + SB(b, h) + boff + n * 2048 + k * 1024)
#define MMA(ai, bj, At_, Bt_)                                                                                          \
  do {                                                                                                                 \
    __builtin_amdgcn_s_setprio(1);                                                                                     \
    for (int m = 0; m < 4; ++m)                                                                                        \
      for (int n = 0; n < 2; ++n)                                                                                      \
        for (int k = 0; k < 2; ++k) acc[ai][bj][m][n] = __builtin_amdgcn_mfma_f32_16x16x32_f16(Bt_[n][k], At_[m][k], acc[ai][bj][m][n], 0, 0, 0); \
    __builtin_amdgcn_s_setprio(0);                                                                                     \
  } while (0)
  int cpm, cpn, npm, npn, ui = 0;
  if (unit_next(0, (int)gridDim.x, cid, ga.nM, ga.nN, cpm, cpn)) {
    f32x4 acc[2][2][4][2];
#pragma unroll
    for (int a = 0; a < 2; ++a)
#pragma unroll
      for (int b = 0; b < 2; ++b)
#pragma unroll
        for (int m = 0; m < 4; ++m)
#pragma unroll
          for (int n = 0; n < 2; ++n) acc[a][b][m][n] = (f32x4){0.f, 0.f, 0.f, 0.f};
    f16x8 At[4][2], B0[2][2], B1[2][2];
    {
      UNIT_BASES(cpm, cpn, pa1, pa2, pb)
      STAGE_B(SB(0, 0), BPTR(pb, 0)); STAGE_A(SA(0, 0), APTR(pa1, pa2, 0)); STAGE_B(SB(0, 1), BPTR(pb, 0) + hstepB); STAGE_A(SA(0, 1), APTR(pa1, pa2, 0) + hstepA);
      if (wr == 1) BAR;
      WAIT_V(4); BAR;
      STAGE_B(SB(1, 0), BPTR(pb, 1)); STAGE_A(SA(1, 0), APTR(pa1, pa2, 1)); STAGE_B(SB(1, 1), BPTR(pb, 1) + hstepB);
      WAIT_V(6); BAR;
    }
    for (;;) {
      const bool has_next = unit_next(ui + 1, (int)gridDim.x, cid, ga.nM, ga.nN, npm, npn);
      const int xpm = has_next ? npm : cpm, xpn = has_next ? npn : cpn;
      UNIT_BASES(cpm, cpn, ca1, ca2, cb)
      UNIT_BASES(xpm, xpn, xa1, xa2, xb)
      for (int t = 0; t < nt; t += 2) {
        const bool last = (t == nt - 2);
        const char* a1 = APTR(ca1, ca2, t + 1);
        const char* a2 = last ? APTR(xa1, xa2, 0) : APTR(ca1, ca2, t + 2);
        const char* b2 = last ? BPTR(xb, 0) : BPTR(cb, t + 2);
        const char* a3 = last ? APTR(xa1, xa2, 1) : APTR(ca1, ca2, t + 3);
        const char* b3 = last ? BPTR(xb, 1) : BPTR(cb, t + 3);
        LDB(B0, 0, 0); SCHED; LDA(At, 0, 0); STAGE_A(SA(1, 1), a1 + hstepA);
        WAIT_L(8); BAR; WAIT_L(0); MMA(0, 0, At, B0); BAR; SCHED;
        LDB(B1, 0, 1); STAGE_B(SB(0, 0), b2);
        BAR; WAIT_L(0); MMA(0, 1, At, B1); BAR;
        LDA(At, 0, 1); STAGE_A(SA(0, 0), a2);
        BAR; WAIT_L(0); MMA(1, 0, At, B0); BAR; SCHED;
        STAGE_B(SB(0, 1), b2 + hstepB);
        WAIT_V(6); BAR; MMA(1, 1, At, B1); BAR;
        LDB(B0, 1, 0); SCHED; LDA(At, 1, 0); STAGE_A(SA(0, 1), a2 + hstepA);
        WAIT_L(8); BAR; WAIT_L(0); MMA(0, 0, At, B0); BAR; SCHED;
        LDB(B1, 1, 1); STAGE_B(SB(1, 0), b3);
        BAR; WAIT_L(0); MMA(0, 1, At, B1); BAR;
        LDA(At, 1, 1); STAGE_A(SA(1, 0), a3);
        BAR; WAIT_L(0); MMA(1, 0, At, B0); BAR; SCHED;
        STAGE_B(SB(1, 1), b3 + hstepB);
        WAIT_V(6); BAR; MMA(1, 1, At, B1); BAR;
      }
      epi_direct<EPI>(p, ga, acc, cpm, cpn, wr, wc, fr, fq);
      if (!has_next) break;
#pragma unroll
      for (int a = 0; a < 2; ++a)
#pragma unroll
        for (int b = 0; b < 2; ++b)
#pragma unroll
          for (int m = 0; m < 4; ++m)
#pragma unroll
            for (int n = 0; n < 2; ++n) acc[a][b][m][n] = (f32x4){0.f, 0.f, 0.f, 0.f};
      cpm = npm; cpn = npn; ++ui;
    }
    WAIT_V(0);
    if (wr == 0) BAR;
    BAR;
  }
#undef SA
#undef SB
#undef LDSU
#undef APTR
#undef BPTR
#undef UNIT_BASES
#undef STAGE_A
#undef STAGE_B
#undef LDA
#undef LDB
#undef MMA
}

DI void phase_attn(const PA& p, unsigned char* smem) {
  const int tid = vtid(), lane = tid & 63, wave = tid >> 6, g = lane >> 4, c16 = lane & 15;
  f16* sK = (f16*)smem;
  u16* sV = (u16*)(smem + 3 * 64 * 72 * 2);
  const f16* Q = (const f16*)(p.ws + A_Q);
  const f16* Kb = (const f16*)(p.ws + A_K);
  const u16* VT = (const u16*)(p.ws + A_VT);
  f16* O = (f16*)(p.ws + A_O);
  const int lr = tid >> 3, lc = (tid & 7) * 8;
  for (int u = vbid(); u < 4224; u += vgrid()) {
    int b, qb, head, isctx;
    if (u < 4096) { b = u >> 10; qb = (u >> 4) & 63; head = u & 15; isctx = 0; }
    else { int uu = u - 4096; b = uu >> 5; qb = (uu >> 4) & 1; head = uu & 15; isctx = 1; }
    const int kvh = head >> 2;
    const int qtok0 = isctx ? T_LAT + b * 256 + qb * 128 : b * 8192 + qb * 128;
    f16x8 qf[2][2];
#pragma unroll
    for (int nt = 0; nt < 2; ++nt)
#pragma unroll
      for (int ks = 0; ks < 2; ++ks)
        qf[nt][ks] = *(const f16x8*)(Q + (size_t)(qtok0 + wave * 32 + nt * 16 + c16) * 1024 + head * 64 + ks * 32 + g * 8) * (f16)0.18033688f;
    int w0 = 0, nw = 0;
    if (!isctx) { w0 = (qb == 0) ? 2 : 0; int w1 = (qb == 63) ? 3 : 5; nw = w1 - w0 + 1; }
    const int ntile = nw + 4;
    f32x4 oacc[4][2];
#pragma unroll
    for (int i = 0; i < 4; ++i)
#pragma unroll
      for (int j = 0; j < 2; ++j) oacc[i][j] = (f32x4){0.f, 0.f, 0.f, 0.f};
    float lsum[2] = {0.f, 0.f};
    uint4 rk0, rk1, rv0, rv1, sk0, sk1, sv0, sv1;
    const size_t vrow = (size_t)((b * 4 + kvh) * 64);
#define gload(TT, K0, K1, V0, V1)                                                                      \
  {                                                                                                    \
    const int t_ = (TT);                                                                               \
    int ktok0, tpos0;                                                                                  \
    if (t_ < nw) { int kp0 = (qb - 1) * 128 + (w0 + t_) * 64; ktok0 = b * 8192 + kp0; tpos0 = kp0; }    \
    else { int ct = t_ - nw; ktok0 = T_LAT + b * 256 + ct * 64; tpos0 = 8192 + ct * 64; }              \
    K0 = *(const uint4*)(Kb + (size_t)(ktok0 + lr) * 256 + kvh * 64 + lc);                             \
    K1 = *(const uint4*)(Kb + (size_t)(ktok0 + lr + 32) * 256 + kvh * 64 + lc);                        \
    V0 = *(const uint4*)(VT + (vrow + lr) * 8448 + tpos0 + lc);                                        \
    V1 = *(const uint4*)(VT + (vrow + lr + 32) * 8448 + tpos0 + lc);                                   \
  }
#define swrite(BUF)                                                   \
  {                                                                   \
    *(uint4*)(sK + ((BUF) * 64 + lr) * 72 + lc) = rk0;                \
    *(uint4*)(sK + ((BUF) * 64 + lr + 32) * 72 + lc) = rk1;           \
    *(uint4*)(sV + ((BUF) * 64 + lr) * 72 + lc) = rv0;                \
    *(uint4*)(sV + ((BUF) * 64 + lr + 32) * 72 + lc) = rv1;           \
  }
#define ATT_QK(DST, BUF)                                                                               \
  {                                                                                                    \
    _Pragma("unroll") for (int mt = 0; mt < 4; ++mt) {                                                 \
      const f16x8 a0_ = *(const f16x8*)(sK + ((BUF) * 64 + mt * 16 + c16) * 72 + g * 8);               \
      const f16x8 a1_ = *(const f16x8*)(sK + ((BUF) * 64 + mt * 16 + c16) * 72 + 32 + g * 8);          \
      _Pragma("unroll") for (int nt = 0; nt < 2; ++nt) {                                               \
        DST[mt][nt] = __builtin_amdgcn_mfma_f32_16x16x32_f16(a0_, qf[nt][0], shiftv, 0, 0, 0);     \
        DST[mt][nt] = __builtin_amdgcn_mfma_f32_16x16x32_f16(a1_, qf[nt][1], DST[mt][nt], 0, 0, 0);    \
      }                                                                                                \
    }                                                                                                  \
  }
    f32x4 S[4][2], Sn[4][2];
    const f32x4 shiftv = {-11.5415603f, -11.5415603f, -11.5415603f, -11.5415603f};
    gload(0, rk0, rk1, rv0, rv1);
    swrite(0);
    gload(1, rk0, rk1, rv0, rv1);
    gload(2, sk0, sk1, sv0, sv1);
    __syncthreads();
    ATT_QK(S, 0)
    swrite(1);
    rk0 = sk0; rk1 = sk1; rv0 = sv0; rv1 = sv1;
    gload(3, sk0, sk1, sv0, sv1);
    __syncthreads();
    int bcur = 0;
#define ATT_SOFTMAX(SC, MODE)                                                                           \
  _Pragma("unroll") for (int nt = 0; nt < 2; ++nt) {                                                    \
    const int dbase = kpos0 + g * 4 - (qb * 128 + wave * 32 + nt * 16 + c16);                           \
    _Pragma("unroll") for (int mt = 0; mt < 4; ++mt)                                                    \
      _Pragma("unroll") for (int i = 0; i < 4; ++i) {                                                   \
        float pv = __builtin_amdgcn_exp2f(SC[mt][nt][i]);                                               \
        if (MODE == 1) pv = (dbase >= -128 - mt * 16 - i) ? pv : 0.f;                                   \
        if (MODE == 2) pv = (dbase <= 128 - mt * 16 - i) ? pv : 0.f;                                    \
        lsum[nt] += pv;                                                                                 \
        SC[mt][nt][i] = pv;                                                                             \
      }                                                                                                 \
  }
#define ATT_BODY(SC, SN, TT)                                                                            \
  {                                                                                                     \
    const int t = (TT);                                                                                 \
    const int bnext = bcur == 2 ? 0 : bcur + 1;                                                         \
    const int bstage = bnext == 2 ? 0 : bnext + 1;                                                      \
    if (t + 1 < ntile) ATT_QK(SN, bnext)     \
    const int wi = w0 + t;                                                                              \
    const int mmode = (t < nw) ? (wi < 2 ? 1 : (wi >= 4 ? 2 : 0)) : 0;                                  \
    const int kpos0 = (qb - 1) * 128 + wi * 64;                                                         \
    if (mmode == 0) { ATT_SOFTMAX(SC, 0) } else if (mmode == 1) { ATT_SOFTMAX(SC, 1) } else { ATT_SOFTMAX(SC, 2) } \
    _Pragma("unroll") for (int ks = 0; ks < 2; ++ks) {                                                  \
      f16x8 pb[2];                                                                                      \
      _Pragma("unroll") for (int nt = 0; nt < 2; ++nt) {                                                \
        uint4 w = make_uint4(__builtin_bit_cast(unsigned, __builtin_amdgcn_cvt_pkrtz(SC[2 * ks][nt][0], SC[2 * ks][nt][1])),          \
                             __builtin_bit_cast(unsigned, __builtin_amdgcn_cvt_pkrtz(SC[2 * ks][nt][2], SC[2 * ks][nt][3])),          \
                             __builtin_bit_cast(unsigned, __builtin_amdgcn_cvt_pkrtz(SC[2 * ks + 1][nt][0], SC[2 * ks + 1][nt][1])),  \
                             __builtin_bit_cast(unsigned, __builtin_amdgcn_cvt_pkrtz(SC[2 * ks + 1][nt][2], SC[2 * ks + 1][nt][3]))); \
        pb[nt] = __builtin_bit_cast(f16x8, w);                                                          \
      }                                                                                                 \
      _Pragma("unroll") for (int dt = 0; dt < 4; ++dt) {                                                \
        const u16* vp = sV + (bcur * 64 + dt * 16 + c16) * 72 + ks * 32 + g * 4;                        \
        uint2 lo = *(const uint2*)vp, hi = *(const uint2*)(vp + 16);                                    \
        f16x8 av = __builtin_bit_cast(f16x8, make_uint4(lo.x, lo.y, hi.x, hi.y));                       \
        _Pragma("unroll") for (int nt = 0; nt < 2; ++nt) oacc[dt][nt] = __builtin_amdgcn_mfma_f32_16x16x32_f16(av, pb[nt], oacc[dt][nt], 0, 0, 0); \
      }                                                                                                 \
    }                                                                                                   \
    if (t + 2 < ntile) swrite(bstage);                           \
    rk0 = sk0; rk1 = sk1; rv0 = sv0; rv1 = sv1;                                                         \
    if (t + 4 < ntile) gload(t + 4, sk0, sk1, sv0, sv1);                                                \
    bcur = bnext;                                                                                       \
    __syncthreads();                                                                                    \
  }
    for (int tt = 0; tt < ntile; tt += 2) {
      ATT_BODY(S, Sn, tt)
      ATT_BODY(Sn, S, tt + 1)
    }
#undef ATT_SOFTMAX
#undef ATT_BODY
    const float sinkv = __expf(p.in(13)[head] - 8.f);
#pragma unroll
    for (int nt = 0; nt < 2; ++nt) {
      float l = lsum[nt];
      l += bperm_xor(l, lane, 16);
      l += bperm_xor(l, lane, 32);
      const float inv = 1.f / (l + sinkv);
      f16* op = O + (size_t)(qtok0 + wave * 32 + nt * 16 + c16) * 1024 + head * 64 + g * 4;
#pragma unroll
      for (int dt = 0; dt < 4; ++dt)
        *(uint2*)(op + dt * 16) = make_uint2(pack_h2(oacc[dt][nt][0] * inv, oacc[dt][nt][1] * inv), pack_h2(oacc[dt][nt][2] * inv, oacc[dt][nt][3] * inv));
    }
  }
#undef gload
#undef swrite
#undef ATT_QK
}

DI float allred8(float x) { DPP_ADD(x, 0xB1); DPP_ADD(x, 0x4E); DPP_ADD(x, 0x141); return x; }
DI void phase_scan(const PA& p, unsigned char* smem) {
  constexpr int BUFF = 6144;
  constexpr int NCH = 528;
  float* sm = (float*)smem;
  const int tid = opaque_tid(), lane = tid & 63, wave = __builtin_amdgcn_readfirstlane(tid >> 6), g = lane >> 4, c16 = lane & 15;
  const f16* R = (const f16*)(p.ws + A_R);
  const f16* KP = (const f16*)(p.ws + A_KP);
  const f16* V = (const f16*)(p.ws + A_V);
  const f16* KKN = (const f16*)(p.ws + A_KKN);
  const f16* BVv = (const f16*)(p.ws + A_BV);
  const f16* TW = (const f16*)(p.ws + A_TW);
  const f16* W2D = (const f16*)(p.ws + OFF_W2DEC);
  for (int item = blockIdx.x; item < 256; item += gridDim.x) {
    const int seq = item >> 1, rh = item & 1, dir = seq >> 6, bh = seq & 63, b = bh >> 4, h = bh & 15;
    const int sgn = dir ? -1 : 1;
    auto cbase = [&](int c) -> int {
      if (dir == 0) return c < 16 ? T_LAT + b * 256 + c * 16 : b * 8192 + (c - 16) * 16;
      return c < 16 ? T_LAT + b * 256 + 255 - c * 16 : b * 8192 + 8191 - (c - 16) * 16;
    };
    if (wave >= 4) {
      const int lt = tid & 255, wq = wave & 3;
      f16* Y = (f16*)(p.ws + (dir ? A_YB : A_YF));
      const f16x8 wb0 = *(const f16x8*)(W2D + (size_t)(dir * 1024 + h * 64 + wq * 16 + c16) * 64 + g * 8);
      const f16x8 wb1 = *(const f16x8*)(W2D + (size_t)(dir * 1024 + h * 64 + wq * 16 + c16) * 64 + 32 + g * 8);
      const float w0v = p.in(17)[dir * 1024 + h * 64 + wq * 16 + c16];
      const int offTW = sgn * c16 * 128 + dir * 64 + g * 8;
      const int offR4 = sgn * (g * 4) * 1024 + h * 64 + wq * 16 + c16;
      const int offE = sgn * (lt >> 4) * 1024 + h * 64 + (lt & 15) * 4;
      const int offV0 = sgn * (lt >> 5) * 1024 + h * 64 + rh * 32 + (lt & 31);
      f16x8 twa0, twa1, twb0, twb1;
      f16 ra0, ra1, ra2, ra3, rb0, rb1, rb2, rb3, va0, va1, vb0, vb1;
      uint2 kka, bva, kpa, rra, kkb, bvb, kpb, rrb;
#define LD_GLOAD(C, TW0, TW1, R0, R1, R2, R3, KK, BV, KPv, RR, V0, V1)                 \
  {                                                                                    \
    const int cb_ = cbase(C);                                                          \
    const f16* tp_ = TW + (size_t)cb_ * 128 + offTW;                                   \
    TW0 = *(const f16x8*)tp_; TW1 = *(const f16x8*)(tp_ + 32);                         \
    const f16* rp_ = R + (size_t)cb_ * 1024 + offR4;                                   \
    R0 = rp_[0]; R1 = rp_[sgn * 1024]; R2 = rp_[sgn * 2048]; R3 = rp_[sgn * 3072];     \
    const size_t o_ = (size_t)cb_ * 1024 + offE;                                       \
    KK = *(const uint2*)(KKN + o_); BV = *(const uint2*)(BVv + o_);                    \
    KPv = *(const uint2*)(KP + o_);                                                    \
    V0 = V[(size_t)cb_ * 1024 + offV0]; V1 = V[(size_t)cb_ * 1024 + offV0 + sgn * 8192]; \
  }
#define LD_PROCESS(BUF, TW0, TW1, R0, R1, R2, R3, KK, BV, KPv, RR, V0, V1)             \
  {                                                                                    \
    float* B_ = sm + (BUF) * BUFF;                                                     \
    f32x4 ca = (f32x4){0.f, 0.f, 0.f, 0.f};                                            \
    ca = __builtin_amdgcn_mfma_f32_16x16x32_f16(TW0, wb0, ca, 0, 0, 0);                \
    ca = __builtin_amdgcn_mfma_f32_16x16x32_f16(TW1, wb1, ca, 0, 0, 0);                \
    const int ch_ = wq * 16 + c16;                                                     \
    const float rf_[4] = {(float)R0, (float)R1, (float)R2, (float)R3};                 \
    _Pragma("unroll") for (int i = 0; i < 4; ++i) {                                    \
      const float z_ = w0v + ca[i];                                                    \
      const float w_ = __expf(-0.60653066f * __builtin_amdgcn_rcpf(1.f + __expf(-z_)));     \
      B_[2048 + (g * 4 + i) * 64 + ch_] = w_;                                          \
      B_[1024 + (g * 4 + i) * 64 + ch_] = rf_[i];     \
    }                                                                                  \
    const f16x4 kk = __builtin_bit_cast(f16x4, KK), bv = __builtin_bit_cast(f16x4, BV), kp = __builtin_bit_cast(f16x4, KPv); \
    const int st_ = lt >> 4, c4_ = (lt & 15) * 4;                                      \
    *(float4*)(B_ + st_ * 64 + c4_) = make_float4(-(float)kk[0], -(float)kk[1], -(float)kk[2], -(float)kk[3]);          \
    *(float4*)(B_ + 3072 + st_ * 64 + c4_) = make_float4((float)bv[0], (float)bv[1], (float)bv[2], (float)bv[3]);      \
    *(float4*)(B_ + 4096 + st_ * 64 + c4_) = make_float4((float)kp[0], (float)kp[1], (float)kp[2], (float)kp[3]);      \
    B_[5120 + ((lt >> 5) * 16 + ((lt & 31) >> 1)) * 4 + (lt & 1)] = (float)V0;         \
    B_[5120 + (((lt >> 5) + 8) * 16 + ((lt & 31) >> 1)) * 4 + (lt & 1)] = (float)V1;   \
  }
#define Y_FLUSH(CC, YB) {     \
          const float* yp_ = sm + 2 * BUFF + (YB) * 8192 + ((lt >> 4) * 16 + (lt & 15)) * 32;                                          \
          float ya_ = 0.f, yb_ = 0.f;                                                                                                  \
          _Pragma("unroll") for (int q_ = 0; q_ < 8; ++q_) {                                                                           \
            const float4 t_ = *(const float4*)(yp_ + (((q_ + lt) & 7) << 2));     \
            ya_ += t_.x + t_.z; yb_ += t_.y + t_.w;                                                                                    \
          }                                                                                                                            \
          *(unsigned*)(Y + (size_t)(cbase(CC) + sgn * (lt >> 4)) * 1024 + h * 64 + rh * 32 + 2 * (lt & 15)) = pack_h2(ya_, yb_);       \
        }
#define LD_GLOAD_S(C, X) LD_GLOAD(C, tw##X##0, tw##X##1, r##X##0, r##X##1, r##X##2, r##X##3, kk##X, bv##X, kp##X, rr##X, v##X##0, v##X##1)
#define LD_PROCESS_S(BUF, X) LD_PROCESS(BUF, tw##X##0, tw##X##1, r##X##0, r##X##1, r##X##2, r##X##3, kk##X, bv##X, kp##X, rr##X, v##X##0, v##X##1)
#define ROT(X, Y) tw##X##0 = tw##Y##0; tw##X##1 = tw##Y##1; r##X##0 = r##Y##0; r##X##1 = r##Y##1; r##X##2 = r##Y##2; r##X##3 = r##Y##3; \
                  kk##X = kk##Y; bv##X = bv##Y; kp##X = kp##Y; rr##X = rr##Y; v##X##0 = v##Y##0; v##X##1 = v##Y##1;
      f16x8 twc0, twc1, twd0, twd1;
      f16 rc0, rc1, rc2, rc3, rd0, rd1, rd2, rd3, vc0, vc1, vd0, vd1;
      uint2 kkc, bvc, kpc, rrc, kkd, bvd, kpd, rrd;
      LD_GLOAD_S(0, a)
      LD_PROCESS_S(0, a)
      LD_GLOAD_S(1, a)
      __syncthreads();
      for (int c = 0; c < NCH; ++c) {
        const int cur = c & 1;
        if (c + 2 < NCH) LD_GLOAD_S(c + 2, b)
        if (c + 1 < NCH) LD_PROCESS_S(cur ^ 1, a)
        if (c > 16) Y_FLUSH(c - 1, cur ^ 1)
        ROT(a, b)
        __syncthreads();
      }
      Y_FLUSH(NCH - 1, 1)
#undef LD_GLOAD
#undef LD_PROCESS
#undef LD_GLOAD_S
#undef LD_PROCESS_S
#undef ROT
#undef Y_FLUSH
    } else {
      const int rp = tid >> 4, j = tid & 15;
      f32x2 sA01 = {0.f, 0.f}, sA23 = {0.f, 0.f}, sB01 = {0.f, 0.f}, sB23 = {0.f, 0.f};
      __syncthreads();
      for (int c = 0; c < NCH; ++c) {
        const int cur = c & 1;
        const float* B = sm + cur * BUFF;
        float* ypw = sm + 2 * BUFF + cur * 8192 + (rp * 16 + j) * 2;
#define SC_LOAD(S, I)                                                             \
  const f32x4 a##S = *(const f32x4*)(B + (I) * 64 + j * 4);                       \
  const f32x4 r##S = *(const f32x4*)(B + 1024 + (I) * 64 + j * 4);                \
  const f32x4 w##S = *(const f32x4*)(B + 2048 + (I) * 64 + j * 4);                \
  const f32x4 b##S = *(const f32x4*)(B + 3072 + (I) * 64 + j * 4);                \
  const f32x4 k##S = *(const f32x4*)(B + 4096 + (I) * 64 + j * 4);                \
  const f32x2 q##S = *(const f32x2*)(B + 5120 + ((I) * 16 + rp) * 4);
#define SC_STEP(S, I)                                                             \
  {                                                                               \
    f32x2 tA_ = sA01 * a##S.xy; tA_ = sA23 * a##S.zw + tA_;                       \
    f32x2 tB_ = sB01 * a##S.xy; tB_ = sB23 * a##S.zw + tB_;                       \
    float d1A_ = tA_.x + tA_.y, d1B_ = tB_.x + tB_.y;                             \
    d1A_ = allred16(d1A_); d1B_ = allred16(d1B_);                                 \
    const f32x2 dA_ = {d1A_, d1A_}, vA_ = {q##S.x, q##S.x}, dB_ = {d1B_, d1B_}, vB_ = {q##S.y, q##S.y}; \
    f32x2 x_;                                                                     \
    x_ = k##S.xy * vA_; x_ = b##S.xy * dA_ + x_; sA01 = sA01 * w##S.xy + x_;      \
    x_ = k##S.zw * vA_; x_ = b##S.zw * dA_ + x_; sA23 = sA23 * w##S.zw + x_;      \
    x_ = k##S.xy * vB_; x_ = b##S.xy * dB_ + x_; sB01 = sB01 * w##S.xy + x_;      \
    x_ = k##S.zw * vB_; x_ = b##S.zw * dB_ + x_; sB23 = sB23 * w##S.zw + x_;      \
      \
    f32x2 uA_ = sA01 * r##S.xy; uA_ = sA23 * r##S.zw + uA_;                       \
    f32x2 uB_ = sB01 * r##S.xy; uB_ = sB23 * r##S.zw + uB_;                       \
    *(float2*)(ypw + (I) * 512) = make_float2(uA_.x + uA_.y, uB_.x + uB_.y);      \
  }
        {
          SC_LOAD(0, 0) SC_LOAD(1, 1)
          SC_STEP(0, 0) SC_LOAD(2, 2)
          SC_STEP(1, 1) SC_LOAD(3, 3)
          SC_STEP(2, 2) SC_LOAD(4, 4)
          SC_STEP(3, 3) SC_LOAD(5, 5)
          SC_STEP(4, 4) SC_LOAD(6, 6)
          SC_STEP(5, 5) SC_LOAD(7, 7)
          SC_STEP(6, 6) SC_LOAD(8, 8)
          SC_STEP(7, 7) SC_LOAD(9, 9)
          SC_STEP(8, 8) SC_LOAD(10, 10)
          SC_STEP(9, 9) SC_LOAD(11, 11)
          SC_STEP(10, 10) SC_LOAD(12, 12)
          SC_STEP(11, 11) SC_LOAD(13, 13)
          SC_STEP(12, 12) SC_LOAD(14, 14)
          SC_STEP(13, 13) SC_LOAD(15, 15)
          SC_STEP(14, 14)
          SC_STEP(15, 15)
        }
#undef SC_LOAD
#undef SC_STEP
        __syncthreads();
      }
    }
    __syncthreads();
  }
}

DI void phase_readout(const PA& p, unsigned char* smem) {
  const int tid = vtid(), row = tid >> 1, half = tid & 1;
  const float* cr = (const float*)smem + row * 132 + half * 64;
  const f16* Gs = (const f16*)(p.ws + A_G);
  const f16* G2 = (const f16*)(p.ws + OFF_G2);
  const f16* V = (const f16*)(p.ws + A_V);
  const float* RK = (const float*)(p.ws + OFF_RK);
  f16* O1 = (f16*)(p.ws + A_O1);
  for (int t = vbid(); t < 256 * 8; t += vgrid()) {
    const int m = t >> 3, n = t & 7;
    const int tok = m * 128 + row, head = n * 2 + half, ch0 = head * 64;
    f16x2 part[32];
#pragma unroll
    for (int c = 0; c < 32; ++c) part[c] = (f16x2){(f16)0.f, (f16)0.f};
    const float rk = RK[(size_t)tok * 16 + head];
    const float* gng = p.in(28) + ch0; const float* gnb = p.in(29) + ch0;
#pragma unroll 1
    for (int d = 0; d < 2; ++d) {
      f32x4 acc[4][4];
      gemm_mainloop<false>(acc, Gs + (size_t)m * 128 * 256 + d * 128, 256, nullptr, nullptr, G2 + (size_t)d * 1024 * 128 + (size_t)n * 128 * 128, 128, 128, smem);
      stage_c(acc, smem);
      const f16* yp = (const f16*)(p.ws + (d ? A_YB : A_YF)) + (size_t)tok * 1024 + ch0;
      const f16* vp = V + (size_t)tok * 1024 + ch0;
      f16x8 yv[8];
      float mean = 0.f;
#pragma unroll
      for (int q = 0; q < 8; ++q) {
        yv[q] = *(const f16x8*)(yp + q * 8);
#pragma unroll
        for (int e = 0; e < 8; ++e) mean += (float)yv[q][e];
      }
      mean *= (1.f / 64.f);
      float var = 0.f;
#pragma unroll
      for (int q = 0; q < 8; ++q)
#pragma unroll
        for (int e = 0; e < 8; ++e) { float dlt = (float)yv[q][e] - mean; var += dlt * dlt; }
      const float rs = rsqrtf(var * (1.f / 64.f) + 64e-5f);
#pragma unroll
      for (int q = 0; q < 8; ++q) {
        f16x8 vv = *(const f16x8*)(vp + q * 8);
#pragma unroll
        for (int e = 0; e < 8; ++e) {
          const int c = q * 8 + e;
          const float gn = ((float)yv[q][e] - mean) * rs * gng[c] + gnb[c];
          part[c >> 1][c & 1] = (f16)((float)part[c >> 1][c & 1] + (gn + rk * (float)vv[e]) * cr[c]);
        }
      }
      __syncthreads();
    }
    f16* dst = O1 + (size_t)tok * 1024 + ch0;
#pragma unroll
    for (int q = 0; q < 8; ++q)
      *(uint4*)(dst + q * 8) = make_uint4(__builtin_bit_cast(unsigned, part[q * 4]), __builtin_bit_cast(unsigned, part[q * 4 + 1]),
                                          __builtin_bit_cast(unsigned, part[q * 4 + 2]), __builtin_bit_cast(unsigned, part[q * 4 + 3]));
  }
}

__global__ void __launch_bounds__(512) mega(Params p0) {
  extern __shared__ __attribute__((aligned(16))) unsigned char smem[];
  cg::grid_group grid = cg::this_grid();
  volatile LAS unsigned* xb_st = (volatile LAS unsigned*)(smem + 2 * LDS_HALF);
  if (threadIdx.x == 0) { xb_st[0] = 0u; xb_st[1] = 0u; xb_st[2] = 0u; xb_st[3] = blockIdx.x; }
  __syncthreads();
  const XcdBarrier xb = xcd_barrier_post((unsigned*)(p0.ws + OFF_BAR), xb_st);
  for (int ph = p0.ph_lo; ph < p0.ph_hi; ++ph) {
   for (int rep = 0; rep <= (int)((REPEAT_MASK >> ph) & 1u); ++rep) {
    KParams kp = (KParams)__builtin_amdgcn_kernarg_segment_ptr();
    asm volatile("" : "+s"(kp));
    PA p;
    p.k = kp;
    p.ws = kp->ws;
    p.out = kp->out;
    unsigned char* ws = p.ws;
    unsigned char* vsm = smem + vhalf() * LDS_HALF;
    const float* mod = (const float*)(ws + OFF_MOD);
    float* xc = (float*)(ws + OFF_XC);
    BigArgs ba;
    int big = -1;
    switch (ph) {
      case 0: phase0(p, vsm); break;
      case 1: phase_norm(p.in(0), p.in(2), p.in(6), mod, 0, (f16*)(ws + A_H), T_ALL); break;
      case 2: ba = BigArgs{(const f16*)(ws + A_H), (const f16*)(ws + A_H), (const f16*)(ws + A_WQKV), 1024, 1024, 16, 16, 128, 6, GemmArgs{}}; big = EPI_QKV; break;
      case 3: phase_attn(p, vsm); break;
      case 4: ba = BigArgs{(const f16*)(ws + A_O), (const f16*)(ws + A_O), (const f16*)(ws + A_WO0), 1024, 1024, 16, 16, 128, 4,
                           GemmArgs{nullptr, nullptr, 0, 0, 0, 0, 0, 0, p.in(0), p.in(2), p.out, xc, mod + 2 * 1024, nullptr}}; big = EPI_RES; break;
      case 5: phase_norm(p.out, xc, p.in(7), mod, 3, (f16*)(ws + A_H), T_ALL); break;
      case 6: ba = BigArgs{(const f16*)(ws + A_H), (const f16*)(ws + A_H), (const f16*)(ws + A_W1_0), 1024, 1024, 16, 16, 128, 16,
                           GemmArgs{nullptr, nullptr, 0, 0, 0, 0, 0, 0, nullptr, nullptr, nullptr, nullptr, nullptr, (f16*)(ws + A_U)}}; big = EPI_MLP1; break;
      case 7: ba = BigArgs{(const f16*)(ws + A_U), (const f16*)(ws + A_U), (const f16*)(ws + A_W2_0), 4096, 4096, 64, 64, 128, 4,
                           GemmArgs{nullptr, nullptr, 0, 0, 0, 0, 0, 0, p.out, xc, p.out, xc, mod + 5 * 1024, nullptr}}; big = EPI_RES; break;
      case 8: {
        phase_shift(p, vsm);
        int base = T_ALL / 8;
        f16* WF = (f16*)(ws + A_WFEAT);
        const float* mu = p.in(15);
        for (int mm = 0; mm < 3; ++mm) {
          const float* src = p.in(16) + (size_t)mm * 1024 * 1024;
          f16* dst = WF + (size_t)mm * 1024 * 2048;
          conv_job(src, 1024, 1024, dst, 2048, base, vsm);
          conv_job(src, 1024, 1024, dst + 1024, 2048, base, vsm, mu + (mm == 0 ? 0 : (mm == 1 ? 2 : 3)) * 1024);
        }
        for (int d = 0; d < 2; ++d) {
          const float* src = p.in(18) + (size_t)d * 1024 * 64;
          f16* dst = WF + (size_t)(3072 + d * 64) * 2048;
          conv_job(src, 1024, 64, dst, 2048, base, vsm);
          conv_job(src, 1024, 64, dst + 1024, 2048, base, vsm, mu + 1 * 1024);
        }
        conv_job(p.in(21), 1024, 64, WF + (size_t)3200 * 2048, 2048, base, vsm);
        conv_job(p.in(21), 1024, 64, WF + (size_t)3200 * 2048 + 1024, 2048, base, vsm, mu + 4 * 1024);
        for (int d = 0; d < 2; ++d) {
          const float* src = p.in(23) + (size_t)d * 1024 * 128;
          f16* dst = WF + (size_t)(3328 + d * 128) * 2048;
          conv_job(src, 1024, 128, dst, 2048, base, vsm);
          conv_job(src, 1024, 128, dst + 1024, 2048, base, vsm, mu + 5 * 1024);
        }
      } break;
      case 9: ba = BigArgs{(const f16*)(ws + A_H), (const f16*)(ws + A_XX), (const f16*)(ws + A_WFEAT), 1024, 2048, 16, 32, 128, 14, GemmArgs{}}; big = EPI_FEAT; break;
      case 10: {
        GemmArgs ga{(const f16*)(ws + A_AI), (const f16*)(ws + OFF_A2), 64, 64, 64, 264, 8, EPI_B2, nullptr, nullptr, nullptr, nullptr, nullptr, nullptr};
        gemm_phase<EPI_B2>(p, ga, vsm);
      } break;
      case 11: phase_scan(p, smem); break;
      case 12: {
        phase_readout(p, vsm);
        int base = 2048;
        conv_job(p.in(8) + (size_t)1024 * 4096, 1024, 4096, (f16*)(ws + A_W1_1), 1024, base, vsm);
        conv_job(p.in(9) + (size_t)4096 * 1024, 4096, 1024, (f16*)(ws + A_W2_1), 4096, base, vsm);
      } break;
      case 13: ba = BigArgs{(const f16*)(ws + A_O1), (const f16*)(ws + A_O1), (const f16*)(ws + OFF_WO1), 1024, 1024, 16, 16, 128, 4,
                            GemmArgs{nullptr, nullptr, 0, 0, 0, 0, 0, 0, p.out, xc, p.out, xc, mod + 5 * 6144 + 2 * 1024, nullptr}}; big = EPI_RES; break;
      case 14: phase_norm(p.out, xc, p.in(7) + 1024, mod + 5 * 6144, 3, (f16*)(ws + A_H2), T_LAT); break;
      case 15: ba = BigArgs{(const f16*)(ws + A_H2), (const f16*)(ws + A_H2), (const f16*)(ws + A_W1_1), 1024, 1024, 16, 16, 128, 16,
                            GemmArgs{nullptr, nullptr, 0, 0, 0, 0, 0, 0, nullptr, nullptr, nullptr, nullptr, nullptr, (f16*)(ws + A_U1)}}; big = EPI_MLP1; break;
      case 16: ba = BigArgs{(const f16*)(ws + A_U1), (const f16*)(ws + A_U1), (const f16*)(ws + A_W2_1), 4096, 4096, 64, 64, 128, 4,
                            GemmArgs{nullptr, nullptr, 0, 0, 0, 0, 0, 0, p.out, xc, p.out, xc, mod + 5 * 6144 + 5 * 1024, nullptr}}; big = EPI_RES; break;
      default: break;
    }
    if (big == EPI_QKV) gemm256_phase<EPI_QKV>(p, ba, smem);
    else if (big == EPI_RES) gemm256s_phase<EPI_RES>(p, ba, smem);
    else if (big == EPI_MLP1) gemm256s_phase<EPI_MLP1>(p, ba, smem);
    else if (big == EPI_FEAT) gemm256s_phase<EPI_FEAT>(p, ba, smem);
    if (big >= 0 && ba.nM == 128 && ph < 10) {
      GemmArgs ga = ba.e;
      ga.A = ba.A1; ga.Bt = ba.Bt; ga.lda = ba.lda; ga.ldb = ba.ldb; ga.K = ba.nk1 * 64; ga.MT = 8; ga.NT = ba.nN * 2;
      if (big == EPI_QKV) gemm_phase<EPI_QKV>(p, ga, vsm, 256);
      else if (big == EPI_RES) gemm_phase<EPI_RES>(p, ga, vsm, 256);
      else if (big == EPI_MLP1) gemm_phase<EPI_MLP1>(p, ga, vsm, 256);
      else gemm_phase<EPI_FEAT>(p, ga, vsm, 256, ba.A2, (const f16*)(ws + OFF_MU16));
    }
    if (ph + 1 < p0.ph_hi || rep < (int)((REPEAT_MASK >> ph) & 1u)) {
      if (p0.ph_lo < 0) grid.sync();
      if (ph == 0 && rep == 0) {
        xcd_barrier(xb);
        if (threadIdx.x == 0) {
          unsigned* bar = (unsigned*)(p0.ws + OFF_BAR);
          const unsigned per = gridDim.x >> 3;
          bool uniform = (gridDim.x & 7u) == 0u;
#pragma unroll 1
          for (unsigned jx = 0; jx < 16; ++jx) { const unsigned cnt = xb_ld(&bar[XB_XCNT(jx)]); uniform = uniform && (cnt == (jx < 8 ? per : 0u)); }
          xb_st[3] = uniform ? (xb_st[2] * 8u + xb.x) : blockIdx.x;
        }
        __syncthreads();
      } else xcd_barrier(xb);
    }
   }
  }
}

extern "C" void kernel_launch(void* const* d_in, const int* in_sizes, int n_in, void* d_out, int out_size, void* d_ws, size_t ws_size,
                              hipStream_t stream) {
  static int grid_blocks = 0;
  if (!grid_blocks) {
    if (n_in != 31 || ws_size < WS_NEED) { fprintf(stderr, "kernel_launch: unexpected n_in %d or ws_size %zu (< %zu)\n", n_in, ws_size, (size_t)WS_NEED); grid_blocks = -1; return; }
    int dev = 0, cus = 0, per_cu = 0;
    (void)hipGetDevice(&dev);
    (void)hipDeviceGetAttribute(&cus, hipDeviceAttributeMultiprocessorCount, dev);
    (void)hipFuncSetAttribute((const void*)mega, hipFuncAttributeMaxDynamicSharedMemorySize, LDS_BYTES);
    (void)hipOccupancyMaxActiveBlocksPerMultiprocessor(&per_cu, mega, 512, LDS_BYTES);
    if (per_cu < 1) { fprintf(stderr, "kernel_launch: occupancy query says %d blocks/CU\n", per_cu); }
    grid_blocks = cus;
    if (grid_blocks < 16) { fprintf(stderr, "kernel_launch: too few CUs (%d)\n", cus); grid_blocks = -1; return; }
  }
  if (grid_blocks < 0) return;
  Params p{};
  for (int i = 0; i < 31; ++i) p.in[i] = (const float*)d_in[i];
  p.out = (float*)d_out;
  p.ws = (unsigned char*)d_ws;
  p.ph_lo = 0;
  p.ph_hi = NPHASE;
  (void)hipMemsetAsync((unsigned char*)d_ws + OFF_BAR, 0, XCD_BAR_WORDS * sizeof(unsigned), stream);
  void* args[] = {&p};
  hipError_t e = hipLaunchCooperativeKernel((const void*)mega, dim3(grid_blocks), dim3(512), args, LDS_BYTES, stream);
  if (e != hipSuccess) fprintf(stderr, "cooperative launch failed: %s (grid %d)\n", hipGetErrorString(e), grid_blocks);
}
```
